# Optimizing an MI355X kernel written in HIP

```python
import math
import jax, jax.numpy as jnp
from jax import lax
import numpy as np

D_MODEL = 1024
BATCH = 2
SEQ = 8192
DEPTH = 1
DEC_BATCH = 16
DEC_SEQ = 16
PAST_LEN = 4096

CHUNK = 64
N_PAST_CHUNKS = 8
KV_BAND = N_PAST_CHUNKS * CHUNK
N_HEADS = 8
HEAD_DIM = 64
ATTN_WIDTH = N_HEADS * HEAD_DIM
SSM_WIDTH = D_MODEL // 2
GROUP_CH = 16
N_GROUPS = SSM_WIDTH // GROUP_CH
STATE_DIM = 64
REL_CLIP = 128
EPS = 1e-6
NEG_INF = -1e30
DT_MIN = 1e-3
DT_MAX = 1e-1
IN_SPLITS = (ATTN_WIDTH, ATTN_WIDTH, ATTN_WIDTH, ATTN_WIDTH, SSM_WIDTH, SSM_WIDTH, D_MODEL, D_MODEL)
IN_WIDTH = 4 * ATTN_WIDTH + 2 * SSM_WIDTH + 2 * D_MODEL

kernel_name = "chunk_band_attn_s5_gated_parallel_step"


def rms_norm(x, g):
    xf = x.astype(jnp.float32)
    y = xf * lax.rsqrt(jnp.mean(xf * xf, axis=-1, keepdims=True) + EPS) * g.astype(jnp.float32)
    return y.astype(x.dtype)


def project(x, c, norm_g, w_ada, b_ada, w_in, q_norm_g, k_norm_g):
    b, s = x.shape[0], x.shape[1]
    mod = jax.nn.silu(c) @ w_ada + b_ada
    shift, scale, gate = jnp.split(mod, 3, axis=-1)
    h = rms_norm(x, norm_g) * (1.0 + scale[:, None]) + shift[:, None]
    z = h @ w_in
    idx = [int(i) for i in np.cumsum(IN_SPLITS)[:-1]]
    q, k, v, ga, u, gs, ma, ms = jnp.split(z, idx, axis=-1)
    q = rms_norm(q.reshape(b, s, N_HEADS, HEAD_DIM), q_norm_g)
    k = rms_norm(k.reshape(b, s, N_HEADS, HEAD_DIM), k_norm_g)
    v = v.reshape(b, s, N_HEADS, HEAD_DIM)
    return q, k, v, ga, u, gs, ma, ms, gate


def attend(q, k, v, q_pos, k_pos, rel_bias):
    qc = q_pos // CHUNK
    kc = k_pos // CHUNK
    allowed = ((k_pos[:, None, :] >= 0)
               & (kc[:, None, :] <= qc[:, :, None])
               & (kc[:, None, :] >= qc[:, :, None] - N_PAST_CHUNKS))
    rel = jnp.clip(q_pos[:, :, None] - k_pos[:, None, :], -REL_CLIP, REL_CLIP) + REL_CLIP
    bias = jnp.transpose(rel_bias.astype(jnp.float32)[:, rel], (1, 0, 2, 3))
    s = jnp.einsum('bnqhd,bnkhd->bnhqk', q, k).astype(jnp.float32) * (HEAD_DIM ** -0.5) + bias[None]
    s = jnp.where(allowed[None, :, None], s, NEG_INF)
    p = jax.nn.softmax(s, axis=-1).astype(v.dtype)
    return jnp.einsum('bnhqk,bnkhd->bnqhd', p, v)


def attn_prompt(q, k, v, rel_bias):
    b, s = q.shape[0], q.shape[1]
    nc = s // CHUNK

    def band(t):
        tc = t.reshape(b, nc, CHUNK, N_HEADS, HEAD_DIM)
        tp = jnp.pad(tc, ((0, 0), (N_PAST_CHUNKS, 0), (0, 0), (0, 0), (0, 0)))
        return jnp.concatenate([tp[:, i:i + nc] for i in range(N_PAST_CHUNKS + 1)], axis=2)

    qc = q.reshape(b, nc, CHUNK, N_HEADS, HEAD_DIM)
    q_pos = jnp.arange(s).reshape(nc, CHUNK)
    k_chunk = jnp.arange(nc)[:, None] - N_PAST_CHUNKS + jnp.arange(N_PAST_CHUNKS + 1)[None, :]
    k_pos = (k_chunk[:, :, None] * CHUNK + jnp.arange(CHUNK)[None, None, :]).reshape(nc, (N_PAST_CHUNKS + 1) * CHUNK)
    o = attend(qc, band(k), band(v), q_pos, k_pos, rel_bias)
    return o.reshape(b, s, ATTN_WIDTH)


def attn_sample(q, k, v, cache_k, cache_v, rel_bias):
    b, t = q.shape[0], q.shape[1]
    l = cache_k.shape[1]
    kk = jnp.concatenate([cache_k.astype(k.dtype), k], axis=1)[:, None]
    vv = jnp.concatenate([cache_v.astype(v.dtype), v], axis=1)[:, None]
    q_pos = (PAST_LEN + jnp.arange(t))[None]
    k_pos = jnp.concatenate([PAST_LEN - l + jnp.arange(l), PAST_LEN + jnp.arange(t)])[None]
    o = attend(q[:, None], kk, vv, q_pos, k_pos, rel_bias)[:, 0]
    return o.reshape(b, t, ATTN_WIDTH)


def ssm_branch(u, x0_re, x0_im, lambda_re, lambda_im, log_dt, b_re, b_im, c_re, c_im, d_skip, w_glu, b_glu):
    f32 = jnp.float32
    bsz, s = u.shape[0], u.shape[1]
    uf = u.astype(f32)
    ug = uf.reshape(bsz, s, N_GROUPS, GROUP_CH)
    lr, li = lambda_re.astype(f32), lambda_im.astype(f32)
    dt = jnp.exp(log_dt.astype(f32))[:, None]
    mag = jnp.exp(lr * dt)
    a_re, a_im = mag * jnp.cos(li * dt), mag * jnp.sin(li * dt)
    den = lr * lr + li * li
    nr, ni = a_re - 1.0, a_im
    co_re = (nr * lr + ni * li) / den
    co_im = (ni * lr - nr * li) / den
    br, bi = b_re.astype(f32), b_im.astype(f32)
    bb_re = co_re[..., None] * br - co_im[..., None] * bi
    bb_im = co_re[..., None] * bi + co_im[..., None] * br
    bu_re = jnp.einsum('bsgc,gpc->bsgp', ug, bb_re)
    bu_im = jnp.einsum('bsgc,gpc->bsgp', ug, bb_im)
    x0r, x0i = x0_re.astype(f32), x0_im.astype(f32)
    bu_re = bu_re.at[:, 0].add(a_re * x0r - a_im * x0i)
    bu_im = bu_im.at[:, 0].add(a_re * x0i + a_im * x0r)
    ar = jnp.broadcast_to(a_re, bu_re.shape)
    ai = jnp.broadcast_to(a_im, bu_re.shape)

    def combine(e1, e2):
        a1r, a1i, b1r, b1i = e1
        a2r, a2i, b2r, b2i = e2
        return (a1r * a2r - a1i * a2i,
                a1r * a2i + a1i * a2r,
                a2r * b1r - a2i * b1i + b2r,
                a2r * b1i + a2i * b1r + b2i)

    _, _, xr, xi = lax.associative_scan(combine, (ar, ai, bu_re, bu_im), axis=1)
    y = (jnp.einsum('bsgp,gcp->bsgc', xr, c_re.astype(f32))
         - jnp.einsum('bsgp,gcp->bsgc', xi, c_im.astype(f32))).reshape(bsz, s, SSM_WIDTH)
    y = (y + d_skip.astype(f32) * uf).astype(u.dtype)
    a_half, b_half = jnp.split(y @ w_glu + b_glu, 2, axis=-1)
    return a_half * jax.nn.sigmoid(b_half), xr[:, -1], xi[:, -1]


def finish(x, attn_o, ssm_o, ga, gs, ma, ms, gate, w_oa, w_os, w_out):
    branch_a = (attn_o * jax.nn.silu(ga)) @ w_oa
    branch_s = (ssm_o * jax.nn.silu(gs)) @ w_os
    merged = jax.nn.sigmoid(ma) * branch_a + jax.nn.sigmoid(ms) * branch_s
    return x + gate[:, None] * (merged @ w_out)


def setup_inputs(seed: int = 0) -> dict:
    key = jax.random.key(seed)
    ks = jax.random.split(key, 32)
    f32 = jnp.float32
    nrm = lambda k, shp, sc: jax.random.normal(k, shp, f32) * sc
    cache_len = min(KV_BAND, PAST_LEN)
    n_idx = jnp.arange(STATE_DIM, dtype=f32)
    return {
        "x_prompt": nrm(ks[0], (BATCH, SEQ, D_MODEL), 1.0),
        "x_sample": nrm(ks[1], (DEC_BATCH, DEC_SEQ, D_MODEL), 1.0),
        "c_prompt": nrm(ks[2], (BATCH, D_MODEL), 1.0),
        "c_sample": nrm(ks[3], (DEC_BATCH, D_MODEL), 1.0),
        "cache_k": nrm(ks[4], (DEPTH, DEC_BATCH, cache_len, N_HEADS, HEAD_DIM), 1.0),
        "cache_v": nrm(ks[5], (DEPTH, DEC_BATCH, cache_len, N_HEADS, HEAD_DIM), 1.0),
        "state_ssm_re": nrm(ks[6], (DEPTH, DEC_BATCH, N_GROUPS, STATE_DIM), 0.1),
        "state_ssm_im": nrm(ks[7], (DEPTH, DEC_BATCH, N_GROUPS, STATE_DIM), 0.1),
        "norm_g": 1.0 + nrm(ks[8], (DEPTH, D_MODEL), 0.1),
        "w_ada": nrm(ks[9], (DEPTH, D_MODEL, 3 * D_MODEL), 0.5 * D_MODEL ** -0.5),
        "b_ada": nrm(ks[10], (DEPTH, 3 * D_MODEL), 0.02),
        "w_in": nrm(ks[11], (DEPTH, D_MODEL, IN_WIDTH), D_MODEL ** -0.5),
        "q_norm_g": 1.0 + nrm(ks[12], (DEPTH, HEAD_DIM), 0.1),
        "k_norm_g": 1.0 + nrm(ks[13], (DEPTH, HEAD_DIM), 0.1),
        "rel_bias": nrm(ks[14], (DEPTH, N_HEADS, 2 * REL_CLIP + 1), 0.1),
        "lambda_re": -0.5 + nrm(ks[15], (DEPTH, N_GROUPS, STATE_DIM), 0.01),
        "lambda_im": math.pi * n_idx + nrm(ks[16], (DEPTH, N_GROUPS, STATE_DIM), 0.01),
        "log_dt": jax.random.uniform(ks[17], (DEPTH, N_GROUPS), f32, math.log(DT_MIN), math.log(DT_MAX)),
        "b_re": nrm(ks[18], (DEPTH, N_GROUPS, STATE_DIM, GROUP_CH), (2 * GROUP_CH) ** -0.5),
        "b_im": nrm(ks[19], (DEPTH, N_GROUPS, STATE_DIM, GROUP_CH), (2 * GROUP_CH) ** -0.5),
        "c_re": nrm(ks[20], (DEPTH, N_GROUPS, GROUP_CH, STATE_DIM), STATE_DIM ** -0.5),
        "c_im": nrm(ks[21], (DEPTH, N_GROUPS, GROUP_CH, STATE_DIM), STATE_DIM ** -0.5),
        "d_skip": nrm(ks[22], (DEPTH, SSM_WIDTH), 1.0),
        "w_glu": nrm(ks[23], (DEPTH, SSM_WIDTH, 2 * SSM_WIDTH), SSM_WIDTH ** -0.5),
        "b_glu": nrm(ks[24], (DEPTH, 2 * SSM_WIDTH), 0.02),
        "w_oa": nrm(ks[25], (DEPTH, ATTN_WIDTH, D_MODEL), ATTN_WIDTH ** -0.5),
        "w_os": nrm(ks[26], (DEPTH, SSM_WIDTH, D_MODEL), SSM_WIDTH ** -0.5),
        "w_out": nrm(ks[27], (DEPTH, D_MODEL, D_MODEL), D_MODEL ** -0.5),
    }


def reference(x_prompt, x_sample, c_prompt, c_sample, cache_k, cache_v, state_ssm_re, state_ssm_im,
              norm_g, w_ada, b_ada, w_in, q_norm_g, k_norm_g, rel_bias, lambda_re, lambda_im, log_dt,
              b_re, b_im, c_re, c_im, d_skip, w_glu, b_glu, w_oa, w_os, w_out):
    xp, xs = x_prompt, x_sample
    kp_l, vp_l, srp_l, sip_l = [], [], [], []
    ks_l, vs_l, srs_l, sis_l = [], [], [], []
    for l in range(DEPTH):
        ssm_p = (lambda_re[l], lambda_im[l], log_dt[l], b_re[l], b_im[l], c_re[l], c_im[l], d_skip[l], w_glu[l], b_glu[l])
        q, k, v, ga, u, gs, ma, ms, gate = project(xp, c_prompt, norm_g[l], w_ada[l], b_ada[l], w_in[l], q_norm_g[l], k_norm_g[l])
        a_o = attn_prompt(q, k, v, rel_bias[l])
        zeros = jnp.zeros((xp.shape[0], N_GROUPS, STATE_DIM), jnp.float32)
        s_o, sr, si = ssm_branch(u, zeros, zeros, *ssm_p)
        keep = min(KV_BAND, xp.shape[1])
        kp_l.append(k[:, -keep:]); vp_l.append(v[:, -keep:]); srp_l.append(sr); sip_l.append(si)
        xp = finish(xp, a_o, s_o, ga, gs, ma, ms, gate, w_oa[l], w_os[l], w_out[l])
        q, k, v, ga, u, gs, ma, ms, gate = project(xs, c_sample, norm_g[l], w_ada[l], b_ada[l], w_in[l], q_norm_g[l], k_norm_g[l])
        a_o = attn_sample(q, k, v, cache_k[l], cache_v[l], rel_bias[l])
        s_o, sr, si = ssm_branch(u, state_ssm_re[l], state_ssm_im[l], *ssm_p)
        ks_l.append(k); vs_l.append(v); srs_l.append(sr); sis_l.append(si)
        xs = finish(xs, a_o, s_o, ga, gs, ma, ms, gate, w_oa[l], w_os[l], w_out[l])
    return (xp, xs,
            jnp.stack(kp_l), jnp.stack(vp_l), jnp.stack(srp_l), jnp.stack(sip_l),
            jnp.stack(ks_l), jnp.stack(vs_l), jnp.stack(srs_l), jnp.stack(sis_l))
```

```cpp
#include <hip/hip_runtime.h>
#include <hip/hip_cooperative_groups.h>
#include <cstdio>
#include <cstdint>
namespace cg = cooperative_groups;
namespace pg8 {
#define PG8_LAS __attribute__((address_space(3)))
typedef unsigned short bf16_t;
typedef short bf16x8 __attribute__((ext_vector_type(8)));
typedef float f32x4 __attribute__((ext_vector_type(4)));
typedef unsigned u32x4 __attribute__((ext_vector_type(4)));
constexpr int BM = 256, BK = 64, HALF = 128, HTB = HALF * BK * 2  , STAGE_BYTES = 8 * HTB, NXCD = 8, WGM = 8;

__host__ __device__ __forceinline__ int lds_byte(int r, int c) { const int st = (r >> 4) * 2 + (c >> 5), rr = r & 15, cc = c & 31, ob = rr * 64 + cc * 2; return st * 1024 + (ob ^ (((ob >> 9) & 1) << 5)); }
__host__ __device__ __forceinline__ void stage_rc(int b, int& R, int& C) { const int st = b / 1024, sb = b % 1024, swz = sb ^ (((sb >> 9) & 1) << 5); R = (st >> 1) * 16 + swz / 64; C = (st & 1) * 32 + (swz % 64) / 2; }
__host__ __device__ __forceinline__ int perm32(int rho) { const int n = rho >> 4, i = rho & 15; return 8 * (i >> 2) + 4 * n + (i & 3); }

struct Unit { int pm, pn; };
struct Gemm { const bf16_t* A; const bf16_t* Bt; int M, N, K; };

struct StaticOrder {
    int nM, nN, nwg, G, c;
    __host__ __device__ void init(int M, int N, int G_, int c_) { nM = M / BM; nN = N / BM; nwg = nM * nN; G = G_; c = c_; }
    __host__ __device__ bool next(int i, Unit& u) const {
        const long L = (long)i * G + c; if (L >= nwg) return false;
        int wgid = (int)L; { const int q = nwg / NXCD, r = nwg % NXCD, xcd = wgid % NXCD, off = wgid / NXCD; wgid = (xcd < r ? xcd * (q + 1) : r * (q + 1) + (xcd - r) * q) + off; }
        const int nig = WGM * nN, gid = wgid / nig, fm = gid * WGM, gsz = (nM - fm) < WGM ? (nM - fm) : WGM;
        u.pm = fm + ((wgid % nig) % gsz); u.pn = (wgid % nig) / gsz; return true;
    }
    __device__ __forceinline__ void a_ready(const Unit&) const {}
    __device__ __forceinline__ void done(const Unit&) const {}
};

__device__ __forceinline__ unsigned cvt_pk_bf16(float lo, float hi) { unsigned r; asm volatile("v_cvt_pk_bf16_f32 %0, %1, %2" : "=v"(r) : "v"(lo), "v"(hi)); return r; }
template <class Epi, class Sched, bool ALIGN_EPI = false, bool SP2 = false>
__device__ __forceinline__ void gemm_phase(PG8_LAS unsigned char* lds, const Gemm g, const Sched& S, const Epi& E) {
    const int tid = threadIdx.x, wid = __builtin_amdgcn_readfirstlane(tid >> 6), lane = tid & 63, wr = wid >> 2, wc = wid & 3, fr = lane & 15, fq = lane >> 4;
    const int K = g.K, nt = K / BK;
    unsigned voffA[2], voffB[2];
#pragma unroll
    for (int i = 0; i < 2; ++i) { int R, C; stage_rc(tid * 16 + i * 8192, R, C); const int Rb = Epi::PERM ? ((R & ~31) + perm32(R & 31)) : R;
        voffA[i] = (unsigned)(R * K + C) * 2u; voffB[i] = (unsigned)(Rb * K + C) * 2u; }
    const size_t kstep = (size_t)(BK * 2);
    const size_t hstep = (size_t)HALF * K * 2;
    const size_t tstep = 2 * hstep;
    const unsigned ldsw = (unsigned)wid * 1024u;
    const int aoff = lds_byte(wr * 64 + fr, fq * 8), boff = lds_byte(wc * 32 + fr, fq * 8);
#define PG8_SA(b, h) (((b) * 2 + (h)) * HTB)
#define PG8_SB(b, h) ((4 + (b) * 2 + (h)) * HTB)
#define PG8_STAGE(bufoff, gbase, voff) do { _Pragma("unroll") for (int _i = 0; _i < 2; ++_i) \
        __builtin_amdgcn_global_load_lds((const unsigned*)((const char*)(gbase) + (voff)[_i]), (PG8_LAS unsigned*)(lds + (bufoff) + ldsw + _i * 8192), 16, 0, 0); } while (0)
#define PG8_LDA(dst, b, h) do { _Pragma("unroll") for (int m = 0; m < 4; ++m) _Pragma("unroll") for (int k = 0; k < 2; ++k) dst[m][k] = *(const PG8_LAS bf16x8*)(lds + PG8_SA(b, h) + aoff + m * 2048 + k * 1024); } while (0)
#define PG8_LDB(dst, b, h) do { _Pragma("unroll") for (int n = 0; n < 2; ++n) _Pragma("unroll") for (int k = 0; k < 2; ++k) dst[n][k] = *(const PG8_LAS bf16x8*)(lds + PG8_SB(b, h) + boff + n * 2048 + k * 1024); } while (0)
#define PG8_MMA(ai, bj, At, Bt) do { __builtin_amdgcn_s_setprio(1); _Pragma("unroll") for (int m = 0; m < 4; ++m) _Pragma("unroll") for (int n = 0; n < 2; ++n) _Pragma("unroll") for (int k = 0; k < 2; ++k) \
        acc[ai][bj][m][n] = __builtin_amdgcn_mfma_f32_16x16x32_bf16(Bt[n][k], At[m][k], acc[ai][bj][m][n], 0, 0, 0); __builtin_amdgcn_s_setprio(0); } while (0)
#define PG8_WAIT_V(n) asm volatile("s_waitcnt vmcnt(" #n ")" ::: "memory")
#define PG8_WAIT_L(n) asm volatile("s_waitcnt lgkmcnt(" #n ")" ::: "memory")
#define PG8_BAR __builtin_amdgcn_s_barrier()
#define PG8_SCHED __builtin_amdgcn_sched_barrier(0)
    Unit cur, nxt; int ui = 0;
    if (!S.next(0, cur)) return;
    f32x4 acc[2][2][4][2];
#pragma unroll
    for (int a = 0; a < 2; ++a)
#pragma unroll
        for (int b = 0; b < 2; ++b)
#pragma unroll
            for (int m = 0; m < 4; ++m)
#pragma unroll
                for (int n = 0; n < 2; ++n) acc[a][b][m][n] = (f32x4){0.f, 0.f, 0.f, 0.f};
    bf16x8 At[4][2], B0[2][2], B1[2][2];
    const char* cA = (const char*)g.A + (size_t)cur.pm * tstep; const char* cB = (const char*)g.Bt + (size_t)cur.pn * tstep;
    S.a_ready(cur);
    if constexpr (SP2) {
        PG8_STAGE(PG8_SB(0, 0), cB, voffB); PG8_STAGE(PG8_SB(0, 1), cB + hstep, voffB); PG8_STAGE(PG8_SA(0, 0), cA, voffA); PG8_STAGE(PG8_SA(0, 1), cA + hstep, voffA);
        if (wr == 1) PG8_BAR;
        PG8_WAIT_V(2); PG8_BAR;
        PG8_STAGE(PG8_SB(1, 0), cB + kstep, voffB); PG8_STAGE(PG8_SA(1, 0), cA + kstep, voffA); PG8_STAGE(PG8_SB(1, 1), cB + hstep + kstep, voffB);
        PG8_WAIT_V(6); PG8_BAR;
    } else {
        PG8_STAGE(PG8_SB(0, 0), cB, voffB); PG8_STAGE(PG8_SA(0, 0), cA, voffA); PG8_STAGE(PG8_SB(0, 1), cB + hstep, voffB); PG8_STAGE(PG8_SA(0, 1), cA + hstep, voffA);
        if (wr == 1) PG8_BAR;
        PG8_WAIT_V(4); PG8_BAR;
        PG8_STAGE(PG8_SB(1, 0), cB + kstep, voffB); PG8_STAGE(PG8_SA(1, 0), cA + kstep, voffA); PG8_STAGE(PG8_SB(1, 1), cB + hstep + kstep, voffB);
        PG8_WAIT_V(6); PG8_BAR;
    }
    for (;;) {
        const bool has_next = S.next(ui + 1, nxt);
        const char* nA = has_next ? (const char*)g.A + (size_t)nxt.pm * tstep : cA; const char* nB = has_next ? (const char*)g.Bt + (size_t)nxt.pn * tstep : cB;
        for (int t = 0; t < nt; t += 2) {
            if constexpr (Epi::HAS_MID) { if (t == Epi::MID_T) E.mid(acc, cur, wr, wc, fr, fq); }
            const bool last = (t == nt - 2);
            const char* a1 = cA + (size_t)(t + 1) * kstep;
            const char* a2 = last ? nA : cA + (size_t)(t + 2) * kstep; const char* b2 = last ? nB : cB + (size_t)(t + 2) * kstep;
            const char* a3 = a2 + kstep; const char* b3 = b2 + kstep;
            if (last && has_next) S.a_ready(nxt);
            if constexpr (SP2) {
            PG8_LDB(B0, 0, 0); PG8_LDB(B1, 0, 1); PG8_SCHED; PG8_LDA(At, 0, 0); PG8_STAGE(PG8_SA(1, 1), a1 + hstep, voffA);
            PG8_WAIT_V(8); PG8_WAIT_L(0); PG8_BAR; PG8_MMA(0, 0, At, B0); PG8_MMA(0, 1, At, B1); PG8_BAR; PG8_SCHED;
            PG8_LDA(At, 0, 1); PG8_STAGE(PG8_SB(0, 0), b2, voffB); PG8_STAGE(PG8_SB(0, 1), b2 + hstep, voffB); PG8_STAGE(PG8_SA(0, 0), a2, voffA);
            PG8_WAIT_V(8); PG8_WAIT_L(0); PG8_BAR; PG8_MMA(1, 0, At, B0); PG8_MMA(1, 1, At, B1); PG8_BAR; PG8_SCHED;
            PG8_LDB(B0, 1, 0); PG8_LDB(B1, 1, 1); PG8_SCHED; PG8_LDA(At, 1, 0); PG8_STAGE(PG8_SA(0, 1), a2 + hstep, voffA);
            PG8_WAIT_V(8); PG8_WAIT_L(0); PG8_BAR; PG8_MMA(0, 0, At, B0); PG8_MMA(0, 1, At, B1); PG8_BAR; PG8_SCHED;
            PG8_LDA(At, 1, 1); PG8_STAGE(PG8_SB(1, 0), b3, voffB); PG8_STAGE(PG8_SB(1, 1), b3 + hstep, voffB); PG8_STAGE(PG8_SA(1, 0), a3, voffA);
            PG8_WAIT_V(8); PG8_WAIT_L(0); PG8_BAR; PG8_MMA(1, 0, At, B0); PG8_MMA(1, 1, At, B1); PG8_BAR; PG8_SCHED;
            } else {
            PG8_LDB(B0, 0, 0); PG8_SCHED; PG8_LDA(At, 0, 0); PG8_STAGE(PG8_SA(1, 1), a1 + hstep, voffA);
            PG8_WAIT_L(8); PG8_BAR; PG8_WAIT_L(0); PG8_MMA(0, 0, At, B0); PG8_BAR; PG8_SCHED;
            PG8_LDB(B1, 0, 1); PG8_STAGE(PG8_SB(0, 0), b2, voffB);
            PG8_BAR; PG8_WAIT_L(0); PG8_MMA(0, 1, At, B1); PG8_BAR;
            PG8_LDA(At, 0, 1); PG8_STAGE(PG8_SA(0, 0), a2, voffA);
            PG8_BAR; PG8_WAIT_L(0); PG8_MMA(1, 0, At, B0); PG8_BAR; PG8_SCHED;
            PG8_STAGE(PG8_SB(0, 1), b2 + hstep, voffB);
            PG8_WAIT_V(6); PG8_BAR; PG8_MMA(1, 1, At, B1); PG8_BAR;
            PG8_LDB(B0, 1, 0); PG8_SCHED; PG8_LDA(At, 1, 0); PG8_STAGE(PG8_SA(0, 1), a2 + hstep, voffA);
            PG8_WAIT_L(8); PG8_BAR; PG8_WAIT_L(0); PG8_MMA(0, 0, At, B0); PG8_BAR; PG8_SCHED;
            PG8_LDB(B1, 1, 1); PG8_STAGE(PG8_SB(1, 0), b3, voffB);
            PG8_BAR; PG8_WAIT_L(0); PG8_MMA(0, 1, At, B1); PG8_BAR;
            PG8_LDA(At, 1, 1); PG8_STAGE(PG8_SA(1, 0), a3, voffA);
            PG8_BAR; PG8_WAIT_L(0); PG8_MMA(1, 0, At, B0); PG8_BAR; PG8_SCHED;
            PG8_STAGE(PG8_SB(1, 1), b3 + hstep, voffB);
            PG8_WAIT_V(6); PG8_BAR; PG8_MMA(1, 1, At, B1); PG8_BAR;
            }
        }
        if constexpr (ALIGN_EPI) { if (wr == 0) PG8_BAR; }
        if constexpr (!Epi::AFTER_DRAIN) { E(acc, cur, wr, wc, fr, fq); S.done(cur); }
        if (!has_next) break;
#pragma unroll
        for (int a = 0; a < 2; ++a)
#pragma unroll
            for (int b = 0; b < 2; ++b)
#pragma unroll
                for (int m = 0; m < 4; ++m)
#pragma unroll
                    for (int n = 0; n < 2; ++n) acc[a][b][m][n] = (f32x4){0.f, 0.f, 0.f, 0.f};
        cur = nxt; cA = nA; cB = nB; ++ui;
        if constexpr (ALIGN_EPI) { if (wr == 1) PG8_BAR; }
    }
    PG8_WAIT_V(0);
    if constexpr (!ALIGN_EPI) { if (wr == 0) PG8_BAR; }
    PG8_BAR;
    if constexpr (Epi::AFTER_DRAIN) { E.fused(acc, cur, wr, wc, fr, fq, lds, wid, lane); S.done(cur); }
#undef PG8_SA
#undef PG8_SB
#undef PG8_STAGE
#undef PG8_LDA
#undef PG8_LDB
#undef PG8_MMA
#undef PG8_WAIT_V
#undef PG8_WAIT_L
#undef PG8_BAR
#undef PG8_SCHED
}
}

#define DI __device__ __forceinline__
#define LAS __attribute__((address_space(3)))
using pg8::bf16_t; using pg8::bf16x8; using pg8::f32x4; using pg8::u32x4;
typedef float f32x2 __attribute__((ext_vector_type(2)));
typedef float f32x16 __attribute__((ext_vector_type(16)));
typedef unsigned u32x2 __attribute__((ext_vector_type(2)));
typedef __bf16 bf16x2v __attribute__((ext_vector_type(2)));

constexpr int MP = 16384, MT = 16640;
constexpr float LOG2E = 1.4426950408889634f, RMS_EPS = 1e-6f;
constexpr size_t MiB = 1u << 20;
constexpr size_t WS_MOD = 0, MOD_BYTES = 18 * 3072 * 4, CTL_ZERO_BYTES = 256 * 1024;
constexpr size_t WS_BAR = 240 * 1024;
constexpr size_t WS_GATE = 256 * 1024;
constexpr size_t WS_SSM = 1 * MiB;
constexpr size_t SSM_AR = WS_SSM, SSM_AI = SSM_AR + 8192, SSM_ALR = SSM_AI + 8192, SSM_ALI = SSM_ALR + 8192, SSM_BB = SSM_ALI + 8192  , SSM_CB = SSM_BB + 262144  ;
constexpr size_t WS_WIN = 2 * MiB, WS_WGLU = 12 * MiB, WS_WCAT = 13 * MiB  , WS_WOUT = 15 * MiB;
constexpr size_t WS_E = 17 * MiB;
constexpr size_t WS_KSF = 21 * MiB, WS_VSF = 30 * MiB;
constexpr size_t WS_H = 40 * MiB, WS_XCAT = 40 * MiB  , WS_Y = 156 * MiB + 512 * 1024;
constexpr size_t WS_QF = 73 * MiB, WS_KF = 90 * MiB, WS_VF = 107 * MiB, WS_MERGED = 73 * MiB;
constexpr size_t WS_GA = 123 * MiB, WS_U = 140 * MiB, WS_GS = 173 * MiB, WS_MA = 190 * MiB, WS_MSG = 223 * MiB, WS_END = 256 * MiB;
constexpr size_t O1 = 16777216, O2 = 17039360, O3 = 17563648, O4 = 18087936, O5 = 18092032, O6 = 18096128, O7 = 18227200, O8 = 18358272, O9 = 18391040, OUT_TOTAL = 18423808;
constexpr int LDS_BYTES = 163840, BIAS_OFF = 135168;
constexpr int NPH = 8;
#ifndef MK_N_LAUNCHES
#define MK_N_LAUNCHES 1
#endif

DI unsigned pk(float a, float b) { f32x2 v = {a, b}; bf16x2v r = __builtin_convertvector(v, bf16x2v); return __builtin_bit_cast(unsigned, r); }
DI float bflo(unsigned w) { return __uint_as_float(w << 16); }
DI float bfhi(unsigned w) { return __uint_as_float(w & 0xffff0000u); }
DI float ex2(float x) { return __builtin_amdgcn_exp2f(x); }
DI float sigm(float x) { return __builtin_amdgcn_rcpf(1.f + ex2(-x * LOG2E)); }
DI float silu(float x) { return x * sigm(x); }
DI u32x4 pk8(f32x4 a, f32x4 b) { u32x4 w; w.x = pk(a.x, a.y); w.y = pk(a.z, a.w); w.z = pk(b.x, b.y); w.w = pk(b.z, b.w); return w; }
#define MFMA32(a, b, c) __builtin_amdgcn_mfma_f32_32x32x16_bf16((a), (b), (c), 0, 0, 0)
#define MFMA16(a, b, c) __builtin_amdgcn_mfma_f32_16x16x32_bf16((a), (b), (c), 0, 0, 0)
#define LDS_WAIT() asm volatile("s_waitcnt lgkmcnt(0)" ::: "memory")

struct Args { const float* in[28]; float* out; unsigned char* ws; int ph_lo, ph_hi; };

DI int phys_std(int n) { return (n & ~255) | (((n >> 5) & 1) << 7) | (((n >> 6) & 3) << 5) | (n & 31); }
DI int phys_glu(int n) { const int half = n >> 9, j = n & 511; return ((j >> 7) << 8) | (half << 7) | (j & 127); }

struct Epi1 {
    static constexpr bool PERM = true, AFTER_DRAIN = false, HAS_MID = false;
    unsigned char* ws; float* out; const float* qg; const float* kg;
    DI void operator()(const f32x4 (&acc)[2][2][4][2], const pg8::Unit& u, int wr, int wc, int fr, int fq) const {
        const int pn = u.pn; const bool samp = (u.pm == 64);
        const int rbase = u.pm * 256 + wr * 64 + fr;
        if (pn < 4) {
            const bool isk = pn >= 2; const int head = (pn & 1) * 4 + wc;
            const float* gp = isk ? kg : qg; const float sc = isk ? 1.f : 0.125f * LOG2E;
            f32x4 gv[2][2];
#pragma unroll
            for (int bj = 0; bj < 2; ++bj)
#pragma unroll
                for (int n = 0; n < 2; ++n) gv[bj][n] = *(const f32x4*)(gp + 32 * bj + 8 * fq + 4 * n);
#pragma unroll
            for (int ai = 0; ai < 2; ++ai)
#pragma unroll
                for (int m = 0; m < 4; ++m) {
                    float ss = 0.f;
#pragma unroll
                    for (int bj = 0; bj < 2; ++bj)
#pragma unroll
                        for (int n = 0; n < 2; ++n) { const f32x4 x = acc[ai][bj][m][n]; ss += (x.x * x.x + x.y * x.y) + (x.z * x.z + x.w * x.w); }
                    ss += __shfl_xor(ss, 16); ss += __shfl_xor(ss, 32);
                    const float rs = (1.0f / sqrtf(ss * (1.f / 64.f) + RMS_EPS)) * sc;
                    const int row = rbase + ai * 128 + m * 16;
                    int b, t; if (samp) { b = (row - MP) >> 4; t = row & 15; } else { b = row >> 13; t = row & 8191; }
#pragma unroll
                    for (int bj = 0; bj < 2; ++bj) {
                        const f32x4 v0 = acc[ai][bj][m][0] * gv[bj][0] * rs, v1 = acc[ai][bj][m][1] * gv[bj][1] * rs;
                        const u32x4 w = pk8(v0, v1);
                        const int kk = 2 * bj + (fq >> 1), hi = fq & 1;
                        if (!isk) {
                            bf16_t* QF = (bf16_t*)(ws + WS_QF);
                            *(u32x4*)(QF + ((size_t)(row >> 5) * 8 + head) * 2048 + (kk * 64 + (row & 31) + 32 * hi) * 8) = w;
                        } else {
                            const int d0 = 32 * bj + 8 * fq;
                            if (samp) {
                                bf16_t* KSF = (bf16_t*)(ws + WS_KSF);
                                *(u32x4*)(KSF + ((size_t)(b * 8 + head) * 9 + 8) * 4096 + (kk * 64 + t + 32 * hi) * 8) = w;
                                float* o = out + O6 + ((size_t)(b * 16 + t) * 8 + head) * 64 + d0; *(f32x4*)o = v0; *(f32x4*)(o + 4) = v1;
                            } else {
                                bf16_t* KF = (bf16_t*)(ws + WS_KF); const int k64 = t & 63;
                                *(u32x4*)(KF + ((size_t)(b * 8 + head) * 128 + (t >> 6)) * 4096 + (((k64 >> 5) * 4 + kk) * 64 + (k64 & 31) + 32 * hi) * 8) = w;
                                if (t >= 7680) { float* o = out + O2 + ((size_t)(b * 512 + t - 7680) * 8 + head) * 64 + d0; *(f32x4*)o = v0; *(f32x4*)(o + 4) = v1; }
                            }
                        }
                    }
                }
        } else if (pn < 6) {
            const int head = (pn & 1) * 4 + wc;
#pragma unroll
            for (int ai = 0; ai < 2; ++ai)
#pragma unroll
                for (int m = 0; m < 4; ++m) {
                    const int row = rbase + ai * 128 + m * 16;
                    int b, t, k64; bf16_t* tb;
                    if (samp) { b = (row - MP) >> 4; t = row & 15; k64 = t; tb = (bf16_t*)(ws + WS_VSF) + ((size_t)(b * 8 + head) * 9 + 8) * 4096; }
                    else { b = row >> 13; t = row & 8191; k64 = t & 63; tb = (bf16_t*)(ws + WS_VF) + ((size_t)(b * 8 + head) * 128 + (t >> 6)) * 4096; }
                    const int kh = k64 >> 5, half = (k64 >> 4) & 1, k16 = k64 & 15, hik = (k16 >> 2) & 1, jk = (k16 & 3) + 4 * (k16 >> 3);
#pragma unroll
                    for (int bj = 0; bj < 2; ++bj) {
                        bf16_t* dst = tb + ((((kh * 2 + half) * 2 + bj) * 64) + 8 * fq + 32 * hik) * 8 + jk;
                        const f32x4 v0 = acc[ai][bj][m][0], v1 = acc[ai][bj][m][1];
                        const unsigned w0 = pk(v0.x, v0.y), w1 = pk(v0.z, v0.w), w2 = pk(v1.x, v1.y), w3 = pk(v1.z, v1.w);
                        dst[0] = (bf16_t)w0; dst[8] = (bf16_t)(w0 >> 16); dst[16] = (bf16_t)w1; dst[24] = (bf16_t)(w1 >> 16);
                        dst[32] = (bf16_t)w2; dst[40] = (bf16_t)(w2 >> 16); dst[48] = (bf16_t)w3; dst[56] = (bf16_t)(w3 >> 16);
                        const int d0 = 32 * bj + 8 * fq;
                        if (samp) { float* o = out + O7 + ((size_t)(b * 16 + t) * 8 + head) * 64 + d0; *(f32x4*)o = v0; *(f32x4*)(o + 4) = v1; }
                        else if (t >= 7680) { float* o = out + O3 + ((size_t)(b * 512 + t - 7680) * 8 + head) * 64 + d0; *(f32x4*)o = v0; *(f32x4*)(o + 4) = v1; }
                    }
                }
        } else if (pn >= 8 && pn < 10) {
            bf16_t* U = (bf16_t*)(ws + WS_U);
#pragma unroll
            for (int ai = 0; ai < 2; ++ai)
#pragma unroll
                for (int m = 0; m < 4; ++m) {
                    const int row = rbase + ai * 128 + m * 16;
#pragma unroll
                    for (int bj = 0; bj < 2; ++bj) *(u32x4*)(U + (size_t)row * 512 + (pn - 8) * 256 + 64 * wc + 32 * bj + 8 * fq) = pk8(acc[ai][bj][m][0], acc[ai][bj][m][1]);
                }
        } else {
            bf16_t* base; int ld, c0; bool sil;
            if (pn < 8) { base = (bf16_t*)(ws + WS_GA); ld = 512; c0 = (pn - 6) * 256; sil = true; }
            else if (pn < 12) { base = (bf16_t*)(ws + WS_GS); ld = 512; c0 = (pn - 10) * 256; sil = true; }
            else if (pn < 16) { base = (bf16_t*)(ws + WS_MA); ld = 1024; c0 = (pn - 12) * 256; sil = false; }
            else { base = (bf16_t*)(ws + WS_MSG); ld = 1024; c0 = (pn - 16) * 256; sil = false; }
#pragma unroll
            for (int ai = 0; ai < 2; ++ai)
#pragma unroll
                for (int m = 0; m < 4; ++m) {
                    const int row = rbase + ai * 128 + m * 16;
#pragma unroll
                    for (int bj = 0; bj < 2; ++bj) {
                        f32x4 v0 = acc[ai][bj][m][0], v1 = acc[ai][bj][m][1];
#pragma unroll
                        for (int j = 0; j < 4; ++j) { const float s0 = sigm(v0[j]), s1 = sigm(v1[j]); v0[j] = sil ? v0[j] * s0 : s0; v1[j] = sil ? v1[j] * s1 : s1; }
                        *(u32x4*)(base + (size_t)row * ld + c0 + 64 * wc + 32 * bj + 8 * fq) = pk8(v0, v1);
                    }
                }
        }
    }
};

struct EpiGLU {
    static constexpr bool PERM = true, AFTER_DRAIN = false;
    static constexpr bool HAS_MID = false;
    const bf16_t* GSb; bf16_t* XC; const float* bglu;
    DI void operator()(const f32x4 (&acc)[2][2][4][2], const pg8::Unit& u, int wr, int wc, int fr, int fq) const {
        const int col = 128 * u.pn + 32 * wc + 8 * fq, rbase = u.pm * 256 + wr * 64 + fr;
        const f32x4 ba0 = *(const f32x4*)(bglu + col), ba1 = *(const f32x4*)(bglu + col + 4), bb0 = *(const f32x4*)(bglu + 512 + col), bb1 = *(const f32x4*)(bglu + 512 + col + 4);
#pragma unroll
        for (int ai = 0; ai < 2; ++ai)
#pragma unroll
            for (int m = 0; m < 4; ++m) {
                const int row = rbase + ai * 128 + m * 16;
                const u32x4 g = *(const u32x4*)(GSb + (size_t)row * 512 + col);
                f32x4 a0 = acc[ai][0][m][0] + ba0, a1 = acc[ai][0][m][1] + ba1; const f32x4 b0 = acc[ai][1][m][0] + bb0, b1 = acc[ai][1][m][1] + bb1;
#pragma unroll
                for (int j = 0; j < 4; ++j) { a0[j] *= sigm(b0[j]); a1[j] *= sigm(b1[j]); }
                a0.x *= bflo(g.x); a0.y *= bfhi(g.x); a0.z *= bflo(g.y); a0.w *= bfhi(g.y); a1.x *= bflo(g.z); a1.y *= bfhi(g.z); a1.z *= bflo(g.w); a1.w *= bfhi(g.w);
                *(u32x4*)(XC + (size_t)row * 1024 + 512 + col) = pk8(a0, a1);
            }
    }
};

struct EpiCat {
    static constexpr bool PERM = true, AFTER_DRAIN = false, HAS_MID = true; static constexpr int MID_T = 8;
    bf16_t* MG; const bf16_t* GA_; const bf16_t* GS_;
    DI void mid(f32x4 (&acc)[2][2][4][2], const pg8::Unit& u, int wr, int wc, int fr, int fq) const {
        int rbase = u.pm * 256 + wr * 64 + fr;
        asm volatile("" : "+v"(rbase));
#pragma unroll
        for (int ai = 0; ai < 2; ++ai)
#pragma unroll
            for (int m = 0; m < 4; ++m) {
                const int row = rbase + ai * 128 + m * 16;
#pragma unroll
                for (int bj = 0; bj < 2; ++bj) {
                    const size_t off = (size_t)row * 1024 + 256 * u.pn + 64 * wc + 32 * bj + 8 * fq;
                    const u32x4 a = *(const u32x4*)(GA_ + off), c = *(const u32x4*)(GS_ + off);
                    f32x4& v0 = acc[ai][bj][m][0]; f32x4& v1 = acc[ai][bj][m][1];
                    v0.x *= bflo(a.x) * __builtin_amdgcn_rcpf(bflo(c.x)); v0.y *= bfhi(a.x) * __builtin_amdgcn_rcpf(bfhi(c.x)); v0.z *= bflo(a.y) * __builtin_amdgcn_rcpf(bflo(c.y)); v0.w *= bfhi(a.y) * __builtin_amdgcn_rcpf(bfhi(c.y));
                    v1.x *= bflo(a.z) * __builtin_amdgcn_rcpf(bflo(c.z)); v1.y *= bfhi(a.z) * __builtin_amdgcn_rcpf(bfhi(c.z)); v1.z *= bflo(a.w) * __builtin_amdgcn_rcpf(bflo(c.w)); v1.w *= bfhi(a.w) * __builtin_amdgcn_rcpf(bfhi(c.w));
                    asm volatile("" ::: "memory");
                }
            }
    }
    DI void operator()(const f32x4 (&acc)[2][2][4][2], const pg8::Unit& u, int wr, int wc, int fr, int fq) const {
        const int rbase = u.pm * 256 + wr * 64 + fr;
#pragma unroll
        for (int ai = 0; ai < 2; ++ai)
#pragma unroll
            for (int m = 0; m < 4; ++m) {
                const int row = rbase + ai * 128 + m * 16;
#pragma unroll
                for (int bj = 0; bj < 2; ++bj) {
                    const size_t off = (size_t)row * 1024 + 256 * u.pn + 64 * wc + 32 * bj + 8 * fq;
                    const u32x4 g = *(const u32x4*)(GS_ + off);
                    f32x4 v0 = acc[ai][bj][m][0], v1 = acc[ai][bj][m][1];
                    v0.x *= bflo(g.x); v0.y *= bfhi(g.x); v0.z *= bflo(g.y); v0.w *= bfhi(g.y); v1.x *= bflo(g.z); v1.y *= bfhi(g.z); v1.z *= bflo(g.w); v1.w *= bfhi(g.w);
                    *(u32x4*)(MG + off) = pk8(v0, v1);
                }
                asm volatile("" ::: "memory");
            }
    }
};

struct EpiOut {
    static constexpr bool PERM = true, AFTER_DRAIN = false, HAS_MID = false;
    const float* xp; const float* xs; const float* gate; float* out;
    DI void operator()(const f32x4 (&acc)[2][2][4][2], const pg8::Unit& u, int wr, int wc, int fr, int fq) const {
        const int rbase = u.pm * 256 + wr * 64 + fr; const bool samp = (u.pm == 64);
#pragma unroll
        for (int ai = 0; ai < 2; ++ai)
#pragma unroll
            for (int m = 0; m < 4; ++m) {
                const int row = rbase + ai * 128 + m * 16;
                const float* xr = samp ? xs + (size_t)(row - MP) * 1024 : xp + (size_t)row * 1024;
                const int bi = samp ? 2 + ((row - MP) >> 4) : (row >> 13);
#pragma unroll
                for (int bj = 0; bj < 2; ++bj) {
                    const int col = 256 * u.pn + 64 * wc + 32 * bj + 8 * fq;
                    const f32x4 x0 = *(const f32x4*)(xr + col), x1 = *(const f32x4*)(xr + col + 4);
                    const f32x4 g0 = *(const f32x4*)(gate + bi * 1024 + col), g1 = *(const f32x4*)(gate + bi * 1024 + col + 4);
                    float* o = out + (size_t)row * 1024 + col;
                    *(f32x4*)o = x0 + g0 * acc[ai][bj][m][0]; *(f32x4*)(o + 4) = x1 + g1 * acc[ai][bj][m][1];
                }
                asm volatile("" ::: "memory");
            }
    }
};

template <int MODE> DI void p0_transpose_item(const float* W, int K, int N, bf16_t* WT, LAS float* scr, int item, int lane, int ldk = 0, int koff = 0) {
    if (ldk == 0) ldk = K;
    const int nblk = N / 32, kb = item / nblk, nb = item % nblk, k0 = 64 * kb, n0 = 32 * nb;
#pragma unroll 8
    for (int i = 0; i < 32; ++i) { const int kk = 2 * i + (lane >> 5); scr[kk * 33 + (lane & 31)] = __builtin_nontemporal_load(W + (size_t)(k0 + kk) * N + n0 + (lane & 31)); }
    LDS_WAIT();
    const int c = lane & 7, prow = MODE ? phys_glu(n0) : phys_std(n0);
#pragma unroll
    for (int j = 0; j < 4; ++j) { const int n = (lane >> 3) + 8 * j; const LAS float* s = scr + (8 * c) * 33 + n;
        u32x4 o; o.x = pk(s[0 * 33], s[1 * 33]); o.y = pk(s[2 * 33], s[3 * 33]); o.z = pk(s[4 * 33], s[5 * 33]); o.w = pk(s[6 * 33], s[7 * 33]);
        *(u32x4*)(WT + (size_t)(prow + n) * ldk + koff + k0 + 8 * c) = o; }
    LDS_WAIT();
}
constexpr int MODCNT_WORD = (255 * 1024) / 4;
DI void p0_mod_item(const float* cp, const float* cs, const float* w_ada, float* MOD, LAS float* scr, int item, int lane) {
    const int cgp = item % 48, ks = item / 48, col0 = 64 * cgp, k0 = 64 * ks;
#pragma unroll
    for (int r = 0; r < 18; ++r) { const float cv = (r < 2) ? cp[r * 1024 + k0 + lane] : cs[(r - 2) * 1024 + k0 + lane]; scr[lane * 20 + r] = silu(cv); }
    scr[lane * 20 + 18] = 0.f; scr[lane * 20 + 19] = 0.f;
    LDS_WAIT();
    f32x4 a[5];
#pragma unroll
    for (int q = 0; q < 5; ++q) a[q] = (f32x4){0.f, 0.f, 0.f, 0.f};
#pragma unroll 8
    for (int kk = 0; kk < 64; ++kk) { const float w = __builtin_nontemporal_load(w_ada + (size_t)(k0 + kk) * 3072 + col0 + lane);
#pragma unroll
        for (int q = 0; q < 5; ++q) { const f32x4 s = *(const LAS f32x4*)(scr + kk * 20 + 4 * q); a[q] += s * w; } }
#pragma unroll
    for (int r = 0; r < 18; ++r) atomicAdd(MOD + r * 3072 + col0 + lane, a[r >> 2][r & 3]);
    asm volatile("s_waitcnt vmcnt(0)" ::: "memory");
    if (lane == 0) __hip_atomic_fetch_add((unsigned*)MOD + MODCNT_WORD, 1u, __ATOMIC_RELAXED, __HIP_MEMORY_SCOPE_AGENT);
    LDS_WAIT();
}
DI void p0_prep(const Args& A, LAS unsigned char* lds, int tid, int wave, int lane, bool do_mod = true) {
    unsigned char* ws = A.ws;
    LAS float* scr = (LAS float*)(lds + wave * 16384);
    const int gw = blockIdx.x * 8 + wave, NGW = gridDim.x * 8, gtid = blockIdx.x * 512 + tid, NT = gridDim.x * 512;
    if (do_mod) for (int it = wave * (int)gridDim.x + (int)blockIdx.x; it < 768; it += NGW) p0_mod_item(A.in[2], A.in[3], A.in[9], (float*)(ws + WS_MOD), scr, it, lane);
#ifdef REP_MOD
    if (do_mod) for (int it = gw; it < 768; it += NGW) p0_mod_item(A.in[2], A.in[3], A.in[9], (float*)(ws + 39 * MiB), scr, it, lane);
#endif
    constexpr int I_IN = 16 * 160, I_G = 8 * 32, I_O = 8 * 32, I_W = 16 * 32;
    for (int it = (wave >= 3) ? (int)blockIdx.x * 5 + (wave - 3) : I_IN + I_G + 2 * I_O + I_W; it < I_IN + I_G + 2 * I_O + I_W; it += (int)gridDim.x * 5) {
        int r = it;
        if (r < I_IN) { p0_transpose_item<0>(A.in[11], 1024, 5120, (bf16_t*)(ws + WS_WIN), scr, r, lane); continue; } r -= I_IN;
        if (r < I_G) { p0_transpose_item<1>(A.in[23], 512, 1024, (bf16_t*)(ws + WS_WGLU), scr, r, lane); continue; } r -= I_G;
        if (r < I_O) { p0_transpose_item<0>(A.in[25], 512, 1024, (bf16_t*)(ws + WS_WCAT), scr, r, lane, 1024, 0); continue; } r -= I_O;
        if (r < I_O) { p0_transpose_item<0>(A.in[26], 512, 1024, (bf16_t*)(ws + WS_WCAT), scr, r, lane, 1024, 512); continue; } r -= I_O;
        p0_transpose_item<0>(A.in[27], 1024, 1024, (bf16_t*)(ws + WS_WOUT), scr, r, lane);
    }
    if (wave == 7 && blockIdx.x < 32) {
        const int g = blockIdx.x, gtid = g * 64 + lane;
        const float lr = A.in[15][gtid], li = A.in[16][gtid], dt = expf(A.in[17][g]);
        const float mag = expf(lr * dt); float sn, cs; sincosf(li * dt, &sn, &cs);
        const float ar = mag * cs, ai = mag * sn, den = lr * lr + li * li, nr = ar - 1.f, ni = ai;
        const float cr = (nr * lr + ni * li) / den, ci = (ni * lr - nr * li) / den;
        ((float*)(ws + SSM_AR))[gtid] = ar; ((float*)(ws + SSM_AI))[gtid] = ai;
        const float mag64 = expf(64.f * (lr * dt)); float sn64, cs64; sincosf(64.f * (li * dt), &sn64, &cs64);
        ((float*)(ws + SSM_ALR))[gtid] = mag64 * cs64; ((float*)(ws + SSM_ALI))[gtid] = mag64 * sn64;
        f32x2* BB = (f32x2*)(ws + SSM_BB);
#pragma unroll
        for (int c = 0; c < 16; ++c) { const float br = A.in[18][gtid * 16 + c], bi = A.in[19][gtid * 16 + c]; BB[gtid * 16 + c] = (f32x2){cr * br - ci * bi, cr * bi + ci * br}; }
        unsigned* CB = (unsigned*)(ws + SSM_CB); const int p = gtid & 63;
#pragma unroll
        for (int c = 0; c < 16; ++c) { const float c_r = A.in[20][(g * 16 + c) * 64 + p], c_i = A.in[21][(g * 16 + c) * 64 + p]; CB[(g * 16 + c) * 64 + p] = pk(c_r, -c_i); }
    }
    { bf16_t* KSF = (bf16_t*)(ws + WS_KSF); const float* ck = A.in[4];
      for (int idx = gtid; idx < 16 * 512 * 64; idx += NT) {
          const int c8 = idx & 63, t = (idx >> 6) & 511, b = idx >> 15, h = c8 >> 3, d0 = (c8 & 7) * 8;
          const float* s = ck + ((size_t)(b * 512 + t) * 512 + c8 * 8);
          const f32x4 v0 = __builtin_nontemporal_load((const f32x4*)s), v1 = __builtin_nontemporal_load((const f32x4*)(s + 4));
          const int tile = t >> 6, k64 = t & 63, kk = d0 >> 4, hi = (d0 >> 3) & 1;
          *(u32x4*)(KSF + ((size_t)(b * 8 + h) * 9 + tile) * 4096 + (((k64 >> 5) * 4 + kk) * 64 + (k64 & 31) + 32 * hi) * 8) = pk8(v0, v1);
      } }
    { bf16_t* VSF = (bf16_t*)(ws + WS_VSF); const float* cv = A.in[5];
      for (int idx = gtid; idx < 16 * 8 * 8 * 8 * 64; idx += NT) {
          const int ln = idx & 63, frag = (idx >> 6) & 7, tile = (idx >> 9) & 7, h = (idx >> 12) & 7, b = idx >> 15;
          const int dh = frag & 1, half = (frag >> 1) & 1, kh = frag >> 2, d = 32 * dh + (ln & 31), hi = ln >> 5;
          float v[8];
#pragma unroll
          for (int j = 0; j < 8; ++j) { const int key = 64 * tile + 32 * kh + 16 * half + 4 * hi + (j & 3) + 8 * (j >> 2); v[j] = __builtin_nontemporal_load(cv + ((size_t)(b * 512 + key) * 8 + h) * 64 + d); }
          u32x4 w; w.x = pk(v[0], v[1]); w.y = pk(v[2], v[3]); w.z = pk(v[4], v[5]); w.w = pk(v[6], v[7]);
          *(u32x4*)(VSF + ((size_t)(b * 8 + h) * 9 + tile) * 4096 + (frag * 64 + ln) * 8) = w;
      } }
    for (int idx = gtid; idx < 128 * 512; idx += NT) { const int bh = idx >> 9, w = idx & 511; const u32x4 z = {0u, 0u, 0u, 0u};
        *(u32x4*)(ws + WS_KSF + ((size_t)bh * 9 + 8) * 8192 + w * 16) = z; *(u32x4*)(ws + WS_VSF + ((size_t)bh * 9 + 8) * 8192 + w * 16) = z; }
}

DI float wave_sum(float v) {
#pragma unroll
    for (int o = 1; o < 64; o <<= 1) v += __shfl_xor(v, o);
    return v;
}
DI void p1_hnorm(const Args& A, int tid, int wave, int lane) {
    unsigned char* ws = A.ws; const float* MOD = (const float*)(ws + WS_MOD); const float* bada = A.in[10];
    if (tid < 64) { unsigned sp = 0;
        while ((unsigned)__builtin_amdgcn_readfirstlane(__hip_atomic_load((const unsigned*)MOD + MODCNT_WORD, __ATOMIC_RELAXED, __HIP_MEMORY_SCOPE_AGENT)) < 768u && ++sp < (1u << 20)) __builtin_amdgcn_s_sleep(4);
        __builtin_amdgcn_fence(__ATOMIC_ACQUIRE, "agent");
        asm volatile("s_waitcnt vmcnt(0)" ::: "memory"); }
    __syncthreads();
    const int gw = blockIdx.x * 8 + wave, NGW = gridDim.x * 8, gtid = blockIdx.x * 512 + tid;
    if (gtid < 18 * 1024) ((float*)(ws + WS_GATE))[gtid] = MOD[(gtid >> 10) * 3072 + 2048 + (gtid & 1023)] + bada[2048 + (gtid & 1023)];
    bf16_t* H = (bf16_t*)(ws + WS_H); const float* ng = A.in[8];
    for (int blk = gw; blk < MP / 8 + (MT - MP); blk += NGW) {
        const bool samp = blk >= MP / 8; const int m0 = samp ? MP + (blk - MP / 8) : 8 * blk, nr = samp ? 1 : 8;
        const float* xr = samp ? A.in[1] + (size_t)(m0 - MP) * 1024 : A.in[0] + (size_t)m0 * 1024;
        const int bi = samp ? 2 + ((m0 - MP) >> 4) : (m0 >> 13);
        f32x4 a1[4], b1[4];
#pragma unroll
        for (int j = 0; j < 4; ++j) { const int k = 4 * lane + 256 * j;
            b1[j] = *(const f32x4*)(MOD + bi * 3072 + k) + *(const f32x4*)(bada + k);
            a1[j] = *(const f32x4*)(ng + k) * (*(const f32x4*)(MOD + bi * 3072 + 1024 + k) + *(const f32x4*)(bada + 1024 + k) + 1.f); }
        f32x4 v[4], vn[4];
#pragma unroll
        for (int j = 0; j < 4; ++j) v[j] = __builtin_nontemporal_load((const f32x4*)(xr + 4 * lane + 256 * j));
        for (int r = 0; r < nr; ++r) {
            const float* xn = xr + (size_t)(r < nr - 1 ? r + 1 : r) * 1024;
#pragma unroll
            for (int j = 0; j < 4; ++j) vn[j] = __builtin_nontemporal_load((const f32x4*)(xn + 4 * lane + 256 * j));
            float ssq = 0.f;
#pragma unroll
            for (int j = 0; j < 4; ++j) ssq += (v[j].x * v[j].x + v[j].y * v[j].y) + (v[j].z * v[j].z + v[j].w * v[j].w);
            const float rstd = 1.0f / sqrtf(wave_sum(ssq) * (1.f / 1024.f) + RMS_EPS);
#pragma unroll
            for (int j = 0; j < 4; ++j) { const f32x4 h = v[j] * rstd * a1[j] + b1[j];
                u32x2 w; w.x = pk(h.x, h.y); w.y = pk(h.z, h.w); __builtin_nontemporal_store(w, (u32x2*)(H + (size_t)(m0 + r) * 1024 + 4 * lane + 256 * j)); v[j] = vn[j]; }
        }
    }
}

DI bf16x8 ld16(const bf16_t* p) { return *(const bf16x8*)p; }
DI bf16x8 pack8(const f32x16& s, int o) { u32x4 w; w.x = pk(s[o], s[o + 1]); w.y = pk(s[o + 2], s[o + 3]); w.z = pk(s[o + 4], s[o + 5]); w.w = pk(s[o + 6], s[o + 7]); return __builtin_bit_cast(bf16x8, w); }
DI void attn_unit(const bf16_t* qfp, const bf16_t* kfp, const bf16_t* vfp, int ntiles, int nkeys, int dq0, const LAS float* bt,
                  bf16_t* Op, const bf16_t* GAp, int qlo, int qhi, int lane) {
    const int q = lane & 31, hi = lane >> 5;
    bf16x8 qf[4];
#pragma unroll
    for (int kk = 0; kk < 4; ++kk) qf[kk] = ld16(qfp + (kk * 64 + lane) * 8);
    f32x16 o0, o1;
#pragma unroll
    for (int i = 0; i < 16; ++i) { o0[i] = 0.f; o1[i] = 0.f; }
    float mrun = -1e30f, lrun = 0.f;
    bf16x8 kc[8], vf[8];
#pragma unroll
    for (int f = 0; f < 8; ++f) kc[f] = ld16(kfp + (f * 64 + lane) * 8);
#pragma unroll
    for (int f = 0; f < 8; ++f) vf[f] = ld16(vfp + (f * 64 + lane) * 8);
    for (int t = 0; t < ntiles; ++t) {
        const int tn = (t + 1 < ntiles) ? t + 1 : t;
        bf16x8 vn[8];
        const bf16_t* vnp = vfp + (size_t)tn * 4096; const bf16_t* knp = kfp + (size_t)tn * 4096;
#pragma unroll
        for (int f = 0; f < 8; ++f) vn[f] = ld16(vnp + (f * 64 + lane) * 8);
        f32x16 s0, s1;
#pragma unroll
        for (int i = 0; i < 16; ++i) { s0[i] = 0.f; s1[i] = 0.f; }
#pragma unroll
        for (int kk = 0; kk < 4; ++kk) { s0 = MFMA32(kc[kk], qf[kk], s0); s1 = MFMA32(kc[4 + kk], qf[kk], s1); }
#pragma unroll
        for (int f = 0; f < 8; ++f) kc[f] = ld16(knp + (f * 64 + lane) * 8);
        float bc = 0.f;
        if (dq0 - 64 * t - 63 >= 128) { bc = bt[256]; } else {
            const LAS float* bp = bt + (dq0 + q - 64 * t - 4 * hi + 128);
#pragma unroll
            for (int i = 0; i < 16; ++i) { const int kidx = (i & 3) + 8 * (i >> 2); s0[i] += bp[-kidx]; s1[i] += bp[-kidx - 32]; }
        }
        if (64 * t + 64 > nkeys) {
#pragma unroll
            for (int i = 0; i < 16; ++i) { const int key = 64 * t + (i & 3) + 8 * (i >> 2) + 4 * hi;
                if (key >= nkeys) s0[i] = -1e30f;
                if (key + 32 >= nkeys) s1[i] = -1e30f; }
        }
        float tm = fmaxf(s0[0], s1[0]);
#pragma unroll
        for (int i = 1; i < 16; ++i) tm = fmaxf(tm, fmaxf(s0[i], s1[i]));
        tm = fmaxf(tm, __shfl_xor(tm, 32)) + bc;
        const float mnew = fmaxf(mrun, tm), alpha = ex2(mrun - mnew), moff = mnew - bc; mrun = mnew;
        float ls = 0.f;
#pragma unroll
        for (int i = 0; i < 16; ++i) { s0[i] = ex2(s0[i] - moff); s1[i] = ex2(s1[i] - moff); ls += s0[i] + s1[i]; }
        lrun = lrun * alpha + ls;
        if (__any(alpha != 1.0f)) {
#pragma unroll
            for (int i = 0; i < 16; ++i) { o0[i] *= alpha; o1[i] *= alpha; }
        }
        const bf16x8 p00 = pack8(s0, 0), p01 = pack8(s0, 8), p10 = pack8(s1, 0), p11 = pack8(s1, 8);
        o0 = MFMA32(vf[0], p00, o0); o1 = MFMA32(vf[1], p00, o1);
        o0 = MFMA32(vf[2], p01, o0); o1 = MFMA32(vf[3], p01, o1);
        o0 = MFMA32(vf[4], p10, o0); o1 = MFMA32(vf[5], p10, o1);
        o0 = MFMA32(vf[6], p11, o0); o1 = MFMA32(vf[7], p11, o1);
#pragma unroll
        for (int f = 0; f < 8; ++f) vf[f] = vn[f];
    }
    const float lt = lrun + __shfl_xor(lrun, 32), inv = 1.0f / lt;
    if (q >= qlo && q < qhi) {
#pragma unroll
        for (int g4 = 0; g4 < 4; ++g4) {
            const int d0 = 8 * g4 + 4 * hi;
            { const u32x2 ga = *(const u32x2*)(GAp + (size_t)q * 512 + d0); u32x2 w;
              w.x = pk(o0[4 * g4] * inv * bflo(ga.x), o0[4 * g4 + 1] * inv * bfhi(ga.x)); w.y = pk(o0[4 * g4 + 2] * inv * bflo(ga.y), o0[4 * g4 + 3] * inv * bfhi(ga.y));
              *(u32x2*)(Op + (size_t)q * 1024 + d0) = w; }
            { const u32x2 ga = *(const u32x2*)(GAp + (size_t)q * 512 + 32 + d0); u32x2 w;
              w.x = pk(o1[4 * g4] * inv * bflo(ga.x), o1[4 * g4 + 1] * inv * bfhi(ga.x)); w.y = pk(o1[4 * g4 + 2] * inv * bflo(ga.y), o1[4 * g4 + 3] * inv * bfhi(ga.y));
              *(u32x2*)(Op + (size_t)q * 1024 + 32 + d0) = w; }
        }
    }
}
DI void p3_bias(const Args& A, LAS unsigned char* lds, int tid) {
    LAS float* bt = (LAS float*)(lds + BIAS_OFF);
    for (int i = tid; i < 8 * 704; i += 512) { const int h = i / 704, r = i - h * 704; bt[i] = A.in[14][h * 257 + (r < 256 ? r : 256)] * LOG2E; }
    __syncthreads();
}
DI void p3_attn(const Args& A, LAS unsigned char* lds, int tid, int wave, int lane) {
    unsigned char* ws = A.ws;
    const LAS float* bt = (const LAS float*)(lds + BIAS_OFF);
    const int vb = (gridDim.x % 8 == 0) ? (int)(blockIdx.x % 8) * (int)(gridDim.x / 8) + (int)(blockIdx.x / 8) : (int)blockIdx.x;
    const int gw = vb * 8 + wave, NGW = gridDim.x * 8;
    const bf16_t* QF = (const bf16_t*)(ws + WS_QF); bf16_t* OA = (bf16_t*)(ws + WS_XCAT); const bf16_t* GA = (const bf16_t*)(ws + WS_GA);
    const bool deal = (NGW == 2048);
    for (int it = 0, L = deal ? (gw < 1920 ? gw : 1920 + gw) : gw; L < 3840 + 128; ++it, L = deal ? ((gw < 1920 && it < 2) ? gw + 1920 : 3968) : L + NGW) {
        const int nsub = (L < 3840) ? 1 : 3;
        for (int sub = 0; sub < nsub; ++sub) {
            int b, c, h, qh; bool samp = false;
            if (L < 3840) { qh = L & 1; h = (L >> 1) & 7; const int cc = L >> 4; c = 8 + (cc % 120); b = cc / 120; }
            else { const int w = L - 3840; if (sub == 2) { samp = true; h = w & 7; b = w >> 3; c = 0; qh = 0; }
                   else { qh = w & 1; h = (w >> 1) & 7; b = (w >> 4) & 1; const int cp = w >> 5; c = sub ? 7 - cp : cp; } }
            if (!samp) {
                const int nt = (c < 8 ? c : 8) + 1, c0 = c - nt + 1, row0 = b * 8192 + 64 * c + 32 * qh;
                attn_unit(QF + ((size_t)(row0 >> 5) * 8 + h) * 2048, (const bf16_t*)(ws + WS_KF) + ((size_t)(b * 8 + h) * 128 + c0) * 4096,
                          (const bf16_t*)(ws + WS_VF) + ((size_t)(b * 8 + h) * 128 + c0) * 4096, nt, nt * 64, 64 * (c - c0) + 32 * qh, bt + h * 704,
                          OA + (size_t)row0 * 1024 + h * 64, GA + (size_t)row0 * 512 + h * 64, 0, 32, lane);
            } else {
                const int row0 = MP + 32 * (b >> 1), qo = 16 * (b & 1);
                attn_unit(QF + ((size_t)(row0 >> 5) * 8 + h) * 2048, (const bf16_t*)(ws + WS_KSF) + ((size_t)(b * 8 + h) * 9) * 4096,
                          (const bf16_t*)(ws + WS_VSF) + ((size_t)(b * 8 + h) * 9) * 4096, 9, 528, 512 - qo, bt + h * 704,
                          OA + (size_t)row0 * 1024 + h * 64, GA + (size_t)row0 * 512 + h * 64, qo, qo + 16, lane);
            }
        }
    }
}

constexpr int BPITCH = 528;
DI void ssm_load_bb(const unsigned char* ws, int g, int lane, bf16x8 (&bbf)[4]) {
    const f32x2* BB = (const f32x2*)(ws + SSM_BB);
#pragma unroll
    for (int rt = 0; rt < 4; ++rt) { const int r = 32 * rt + (lane & 31), p = r >> 1, ri = r & 1, hi = lane >> 5; float v[8];
#pragma unroll
        for (int j = 0; j < 8; ++j) { const f32x2 e = BB[(size_t)(g * 64 + p) * 16 + 8 * hi + j]; v[j] = ri ? e.y : e.x; }
        u32x4 w; w.x = pk(v[0], v[1]); w.y = pk(v[2], v[3]); w.z = pk(v[4], v[5]); w.w = pk(v[6], v[7]); bbf[rt] = __builtin_bit_cast(bf16x8, w); }
}
typedef bf16x8 UReg;
DI UReg ssm_ld(const bf16_t* U, int row0, int g, int lane) { return ld16(U + (size_t)(row0 + (lane & 31)) * 512 + g * 16 + 8 * (lane >> 5)); }
template <bool FULL> DI void ssm_block32(f32x2& x, const bf16x8 (&bbf)[4], float ar, float ai, const UReg& ur, int ntok, LAS unsigned char* Bw, int lane) {
    const int tok = lane & 31, hi = lane >> 5;
    const bf16x8 ub = ur;
#pragma unroll
    for (int rt = 0; rt < 4; ++rt) {
        f32x16 d;
#pragma unroll
        for (int i = 0; i < 16; ++i) d[i] = 0.f;
        d = MFMA32(bbf[rt], ub, d);
#pragma unroll
        for (int a4 = 0; a4 < 4; ++a4) *(LAS f32x4*)(Bw + tok * BPITCH + (32 * rt + 8 * a4 + 4 * hi) * 4) = (f32x4){d[4 * a4], d[4 * a4 + 1], d[4 * a4 + 2], d[4 * a4 + 3]};
    }
    asm volatile("" ::: "memory");
#pragma unroll 8
    for (int t = 0; t < ntok; ++t) {
        const f32x2 bu = *(const LAS f32x2*)(Bw + t * BPITCH + 8 * lane);
        const float xr = ar * x.x - ai * x.y + bu.x, xi = ar * x.y + ai * x.x + bu.y;
        x.x = xr; x.y = xi;
        if (FULL) *(LAS unsigned*)(Bw + t * BPITCH + 4 * lane) = pk(xr, xi);
    }
    asm volatile("" ::: "memory");
}
constexpr size_t WS_SCNT = 254 * 1024;
DI void p3_ssmA(const Args& A, LAS unsigned char* lds, int wave, int lane) {
    unsigned char* ws = A.ws;
    const int gw = blockIdx.x * 8 + wave, NGW = gridDim.x * 8, g = gw & 31, gp = g * 64 + lane;
    const float ar = ((const float*)(ws + SSM_AR))[gp], ai = ((const float*)(ws + SSM_AI))[gp];
    bf16x8 bbf[4]; ssm_load_bb(ws, g, lane, bbf);
    const bf16_t* U = (const bf16_t*)(ws + WS_U); unsigned long long* E = (unsigned long long*)(ws + WS_E);
    LAS unsigned char* Bw = lds + wave * (32 * BPITCH);
    const float alr = ((const float*)(ws + SSM_ALR))[gp], ali = ((const float*)(ws + SSM_ALI))[gp];
    for (int qq = gw >> 5; qq < 64; qq += NGW >> 5) {
        const int b = qq >> 5, j0 = (qq & 31) * 4, row0 = b * 8192 + j0 * 64;
        f32x2 x, agg = {0.f, 0.f};
        for (int jj = 0; jj < 4; ++jj) {
            x = (f32x2){0.f, 0.f};
            const UReg u0 = ssm_ld(U, row0 + 64 * jj, g, lane), u1 = ssm_ld(U, row0 + 64 * jj + 32, g, lane);
            ssm_block32<false>(x, bbf, ar, ai, u0, 32, Bw, lane);
            ssm_block32<false>(x, bbf, ar, ai, u1, 32, Bw, lane);
            const float gr = alr * agg.x - ali * agg.y + x.x, gi = alr * agg.y + ali * agg.x + x.y; agg.x = gr; agg.y = gi;
        }
        __hip_atomic_store(E + ((size_t)(qq * 32 + g)) * 64 + lane, ((unsigned long long)__float_as_uint(agg.y) << 32) | __float_as_uint(agg.x), __ATOMIC_RELAXED, __HIP_MEMORY_SCOPE_AGENT);
        asm volatile("s_waitcnt vmcnt(0)" ::: "memory");
        if (lane == 0) __hip_atomic_fetch_add((unsigned*)(ws + WS_SCNT) + (b * 32 + g) * 4, 1u, __ATOMIC_RELAXED, __HIP_MEMORY_SCOPE_AGENT);
    }
}
DI void p4_ssmC(const Args& A, LAS unsigned char* lds, int wave, int lane) {
    unsigned char* ws = A.ws;
    const int gw = blockIdx.x * 8 + wave, NGW = gridDim.x * 8, g = gw & 31, gp = g * 64 + lane;
    const float ar = ((const float*)(ws + SSM_AR))[gp], ai = ((const float*)(ws + SSM_AI))[gp];
    const float alr = ((const float*)(ws + SSM_ALR))[gp], ali = ((const float*)(ws + SSM_ALI))[gp];
    bf16x8 bbf[4]; ssm_load_bb(ws, g, lane, bbf);
    bf16x8 cbf[4];
#pragma unroll
    for (int kk = 0; kk < 4; ++kk) cbf[kk] = ld16((const bf16_t*)(ws + SSM_CB) + (size_t)(g * 16 + (lane & 15)) * 128 + 32 * kk + 8 * (lane >> 4));
    const f32x4 dsk = *(const f32x4*)(A.in[22] + g * 16 + 4 * (lane >> 4));
    const bf16_t* U = (const bf16_t*)(ws + WS_U); bf16_t* Y = (bf16_t*)(ws + WS_Y);
    LAS unsigned char* Bw = lds + wave * (32 * BPITCH);
#define SSM_CPROJ(r0_, nt_) do { for (int tt = 0; tt < (nt_) / 16; ++tt) { f32x4 acc = {0.f, 0.f, 0.f, 0.f}; \
        _Pragma("unroll") for (int kk = 0; kk < 4; ++kk) { const bf16x8 xb = *(const LAS bf16x8*)(Bw + (16 * tt + (lane & 15)) * BPITCH + 64 * kk + 16 * (lane >> 4)); acc = MFMA16(cbf[kk], xb, acc); } \
        const int row = (r0_) + 16 * tt + (lane & 15); const u32x2 ub_ = *(const u32x2*)(U + (size_t)row * 512 + g * 16 + 4 * (lane >> 4)); const f32x4 uu = {bflo(ub_.x), bfhi(ub_.x), bflo(ub_.y), bfhi(ub_.y)}; const f32x4 y = acc + dsk * uu; \
        u32x2 w; w.x = pk(y.x, y.y); w.y = pk(y.z, y.w); *(u32x2*)(Y + (size_t)row * 512 + g * 16 + 4 * (lane >> 4)) = w; } asm volatile("" ::: "memory"); } while (0)
    for (int qq = gw >> 5; qq < 64; qq += NGW >> 5) {
        const int b = qq >> 5, j0 = (qq & 31) * 4, row0 = b * 8192 + j0 * 64;
        UReg u = ssm_ld(U, row0, g, lane);
        f32x2 x = {0.f, 0.f};
        if (j0 > 0) {
            unsigned* cnt = (unsigned*)(ws + WS_SCNT) + (b * 32 + g) * 4; unsigned sp = 0;
            while ((unsigned)__builtin_amdgcn_readfirstlane(__hip_atomic_load(cnt, __ATOMIC_RELAXED, __HIP_MEMORY_SCOPE_AGENT)) < 32u && ++sp < (1u << 22)) __builtin_amdgcn_s_sleep(2);
            const unsigned long long* ep = (const unsigned long long*)(ws + WS_E) + ((size_t)(b * 32) * 32 + g) * 64 + lane;
            const float a2r = alr * alr - ali * ali, a2i = 2.f * alr * ali, a4r = a2r * a2r - a2i * a2i, a4i = 2.f * a2r * a2i;
#pragma unroll 16
            for (int i = 0; i < (qq & 31); ++i) { const unsigned long long eb = __hip_atomic_load(ep + (size_t)i * 2048, __ATOMIC_RELAXED, __HIP_MEMORY_SCOPE_AGENT);
                const float ex = __uint_as_float((unsigned)eb), ey = __uint_as_float((unsigned)(eb >> 32));
                const float xr = a4r * x.x - a4i * x.y + ex, xi = a4r * x.y + a4i * x.x + ey; x.x = xr; x.y = xi; }
        }
        for (int blk = 0; blk < 8; ++blk) {
            const int r0 = row0 + 32 * blk;
            const UReg un = ssm_ld(U, row0 + 32 * (blk < 7 ? blk + 1 : blk), g, lane);
            ssm_block32<true>(x, bbf, ar, ai, u, 32, Bw, lane);
            SSM_CPROJ(r0, 32);
            u = un;
        }
        if (j0 == 124) { A.out[O4 + (b * 32 + g) * 64 + lane] = x.x; A.out[O5 + (b * 32 + g) * 64 + lane] = x.y; }
    }
    for (int su = gw; su < 512; su += NGW) {
        const int b = su >> 5, row0 = MP + b * 16;
        f32x2 x; x.x = A.in[6][(b * 32 + g) * 64 + lane]; x.y = A.in[7][(b * 32 + g) * 64 + lane];
        const UReg u = ssm_ld(U, row0, g, lane);
        ssm_block32<true>(x, bbf, ar, ai, u, 16, Bw, lane);
        SSM_CPROJ(row0, 16);
        A.out[O8 + (b * 32 + g) * 64 + lane] = x.x; A.out[O9 + (b * 32 + g) * 64 + lane] = x.y;
    }
#undef SSM_CPROJ
}

template <int K, int LDA, int LDB> DI void mini_part(const bf16_t* A, int row0, const bf16_t* Bt, int pr0, int pr1, LAS f32x4* red, int wave, int lane) {
    const int m = lane & 31, hi = lane >> 5, k0 = wave * (K / 8);
    const bf16_t* ap = A + (size_t)(row0 + m) * LDA + k0 + 8 * hi; const bf16_t* w0 = Bt + (size_t)(pr0 + m) * LDB + k0 + 8 * hi; const bf16_t* w1 = Bt + (size_t)(pr1 + m) * LDB + k0 + 8 * hi;
    f32x16 d0, d1;
#pragma unroll
    for (int i = 0; i < 16; ++i) { d0[i] = 0.f; d1[i] = 0.f; }
#pragma unroll
    for (int kk = 0; kk < K / 128; ++kk) { const bf16x8 x = ld16(ap + 16 * kk), wa = ld16(w0 + 16 * kk), wb = ld16(w1 + 16 * kk); d0 = MFMA32(wa, x, d0); d1 = MFMA32(wb, x, d1); }
#pragma unroll
    for (int a4 = 0; a4 < 4; ++a4) { red[(wave * 8 + a4) * 64 + lane] = (f32x4){d0[4 * a4], d0[4 * a4 + 1], d0[4 * a4 + 2], d0[4 * a4 + 3]};
                                     red[(wave * 8 + 4 + a4) * 64 + lane] = (f32x4){d1[4 * a4], d1[4 * a4 + 1], d1[4 * a4 + 2], d1[4 * a4 + 3]}; }
}
DI f32x4 mini_sum(const LAS f32x4* red, int ig, int lane) {
    f32x4 sacc = red[ig * 64 + lane];
#pragma unroll
    for (int w = 1; w < 8; ++w) sacc += red[(w * 8 + ig) * 64 + lane];
    return sacc;
}
#define MINI_TASKS(ntask_) for (int task = (int)blockIdx.x; task < (ntask_); task += (int)gridDim.x)
DI void mini_gemm1(const Args& A, LAS unsigned char* lds, int wave, int lane) {
    unsigned char* ws = A.ws; const int m = lane & 31, hi = lane >> 5, tl = wave >> 2, a = wave & 3, dc = 32 * tl + 8 * a + 4 * hi;
    LAS f32x4* red = (LAS f32x4*)lds; LAS float* sq = (LAS float*)(lds + 65536);
    MINI_TASKS(8 * 80) {
        const int rb = task & 7, cb = task >> 3, row0 = MP + 32 * rb, row = row0 + m, b = (row - MP) >> 4, t = row & 15;
        __syncthreads();
        mini_part<1024, 1024, 1024>((const bf16_t*)(ws + WS_H), row0, (const bf16_t*)(ws + WS_WIN), phys_std(64 * cb), phys_std(64 * cb + 32), red, wave, lane);
        __syncthreads();
        f32x4 v = mini_sum(red, wave, lane);
        if (cb < 16) {
            const bool isk = cb >= 8; const int head = cb & 7; const float* gp = isk ? A.in[13] : A.in[12];
            sq[m * 16 + wave * 2 + hi] = (v.x * v.x + v.y * v.y) + (v.z * v.z + v.w * v.w);
            __syncthreads();
            const LAS f32x4* sp = (const LAS f32x4*)(sq + m * 16); const f32x4 s0 = sp[0], s1 = sp[1], s2 = sp[2], s3 = sp[3];
            const float ss = ((s0.x + s0.y) + (s0.z + s0.w)) + ((s1.x + s1.y) + (s1.z + s1.w)) + ((s2.x + s2.y) + (s2.z + s2.w)) + ((s3.x + s3.y) + (s3.z + s3.w));
            const float rs = (1.0f / sqrtf(ss * (1.f / 64.f) + RMS_EPS)) * (isk ? 1.f : 0.125f * LOG2E);
            const int kk = dc >> 4, hq = (dc >> 3) & 1, j0 = dc & 7;
            v = v * *(const f32x4*)(gp + dc) * rs;
            u32x2 w; w.x = pk(v.x, v.y); w.y = pk(v.z, v.w);
            if (!isk) *(u32x2*)((bf16_t*)(ws + WS_QF) + ((size_t)(row >> 5) * 8 + head) * 2048 + (kk * 64 + (row & 31) + 32 * hq) * 8 + j0) = w;
            else { *(u32x2*)((bf16_t*)(ws + WS_KSF) + ((size_t)(b * 8 + head) * 9 + 8) * 4096 + (kk * 64 + t + 32 * hq) * 8 + j0) = w;
                   *(f32x4*)(A.out + O6 + ((size_t)(b * 16 + t) * 8 + head) * 64 + dc) = v; }
        } else if (cb < 24) {
            const int head = cb - 16, hik = (t >> 2) & 1, jk = (t & 3) + 4 * (t >> 3), dr = 8 * a + 4 * hi;
            bf16_t* dst = (bf16_t*)(ws + WS_VSF) + ((size_t)(b * 8 + head) * 9 + 8) * 4096 + ((tl * 64) + dr + 32 * hik) * 8 + jk;
            const unsigned w0 = pk(v.x, v.y), w1 = pk(v.z, v.w);
            dst[0] = (bf16_t)w0; dst[8] = (bf16_t)(w0 >> 16); dst[16] = (bf16_t)w1; dst[24] = (bf16_t)(w1 >> 16);
            *(f32x4*)(A.out + O7 + ((size_t)(b * 16 + t) * 8 + head) * 64 + dc) = v;
        } else if (cb >= 32 && cb < 40) {
            { u32x2 w; w.x = pk(v.x, v.y); w.y = pk(v.z, v.w); *(u32x2*)((bf16_t*)(ws + WS_U) + (size_t)row * 512 + (cb - 32) * 64 + dc) = w; }
        } else {
            bf16_t* base; int ld, c0; bool sil;
            if (cb < 32) { base = (bf16_t*)(ws + WS_GA); ld = 512; c0 = (cb - 24) * 64; sil = true; }
            else if (cb < 48) { base = (bf16_t*)(ws + WS_GS); ld = 512; c0 = (cb - 40) * 64; sil = true; }
            else if (cb < 64) { base = (bf16_t*)(ws + WS_MA); ld = 1024; c0 = (cb - 48) * 64; sil = false; }
            else { base = (bf16_t*)(ws + WS_MSG); ld = 1024; c0 = (cb - 64) * 64; sil = false; }
#pragma unroll
            for (int j = 0; j < 4; ++j) { const float sg = sigm(v[j]); v[j] = sil ? v[j] * sg : sg; }
            u32x2 w; w.x = pk(v.x, v.y); w.y = pk(v.z, v.w);
            *(u32x2*)(base + (size_t)row * ld + c0 + dc) = w;
        }
    }
    __syncthreads();
}
DI void mini_glu(const Args& A, LAS unsigned char* lds, int wave, int lane) {
    unsigned char* ws = A.ws; const int m = lane & 31, hi = lane >> 5; const float* bglu = A.in[24];
    LAS f32x4* red = (LAS f32x4*)lds;
    MINI_TASKS(8 * 16) {
        const int rb = task & 7, jb = task >> 3, row0 = MP + 32 * rb, row = row0 + m;
        __syncthreads();
        mini_part<512, 512, 512>((const bf16_t*)(ws + WS_Y), row0, (const bf16_t*)(ws + WS_WGLU), phys_glu(32 * jb), phys_glu(512 + 32 * jb), red, wave, lane);
        __syncthreads();
        if (wave < 4) {
            const int col = 32 * jb + 8 * wave + 4 * hi; const bf16_t* p = (const bf16_t*)(ws + WS_GS) + (size_t)row * 512 + col;
            f32x4 va = mini_sum(red, wave, lane) + *(const f32x4*)(bglu + col); const f32x4 vb = mini_sum(red, wave + 4, lane) + *(const f32x4*)(bglu + 512 + col);
            const u32x2 g = *(const u32x2*)p;
            va.x *= sigm(vb.x) * bflo(g.x); va.y *= sigm(vb.y) * bfhi(g.x); va.z *= sigm(vb.z) * bflo(g.y); va.w *= sigm(vb.w) * bfhi(g.y);
            u32x2 w; w.x = pk(va.x, va.y); w.y = pk(va.z, va.w); *(u32x2*)((bf16_t*)(ws + WS_XCAT) + (size_t)row * 1024 + 512 + col) = w;
        }
    }
    __syncthreads();
}
DI void mini_branch(const Args& A, LAS unsigned char* lds, int wave, int lane) {
    unsigned char* ws = A.ws; const int m = lane & 31, hi = lane >> 5, dc = 32 * (wave >> 2) + 8 * (wave & 3) + 4 * hi;
    LAS f32x4* red = (LAS f32x4*)lds;
    MINI_TASKS(8 * 16) {
        const int rb = task & 7, cb = task >> 3, row0 = MP + 32 * rb, row = row0 + m;
        __syncthreads();
        mini_part<512, 1024, 1024>((const bf16_t*)(ws + WS_XCAT), row0, (const bf16_t*)(ws + WS_WCAT), phys_std(64 * cb), phys_std(64 * cb + 32), red, wave, lane);
        __syncthreads();
        const f32x4 va = mini_sum(red, wave, lane);
        __syncthreads();
        mini_part<512, 1024, 1024>((const bf16_t*)(ws + WS_XCAT) + 512, row0, (const bf16_t*)(ws + WS_WCAT) + 512, phys_std(64 * cb), phys_std(64 * cb + 32), red, wave, lane);
        __syncthreads();
        const f32x4 vs = mini_sum(red, wave, lane);
        const size_t off = (size_t)row * 1024 + 64 * cb + dc;
        const u32x2 ga = *(const u32x2*)((const bf16_t*)(ws + WS_MA) + off), gs = *(const u32x2*)((const bf16_t*)(ws + WS_MSG) + off);
        u32x2 w; w.x = pk(va.x * bflo(ga.x) + vs.x * bflo(gs.x), va.y * bfhi(ga.x) + vs.y * bfhi(gs.x)); w.y = pk(va.z * bflo(ga.y) + vs.z * bflo(gs.y), va.w * bfhi(ga.y) + vs.w * bfhi(gs.y));
        *(u32x2*)((bf16_t*)(ws + WS_MERGED) + off) = w;
    }
    __syncthreads();
}
DI void mini_out(const Args& A, LAS unsigned char* lds, int wave, int lane) {
    unsigned char* ws = A.ws; const int m = lane & 31, hi = lane >> 5, dc = 32 * (wave >> 2) + 8 * (wave & 3) + 4 * hi; const float* gate = (const float*)(ws + WS_GATE);
    LAS f32x4* red = (LAS f32x4*)lds;
    MINI_TASKS(8 * 16) {
        const int rb = task & 7, cb = task >> 3, row0 = MP + 32 * rb, row = row0 + m, bi = 2 + ((row - MP) >> 4), col = 64 * cb + dc;
        __syncthreads();
        mini_part<1024, 1024, 1024>((const bf16_t*)(ws + WS_MERGED), row0, (const bf16_t*)(ws + WS_WOUT), phys_std(64 * cb), phys_std(64 * cb + 32), red, wave, lane);
        __syncthreads();
        const f32x4 v = mini_sum(red, wave, lane);
        *(f32x4*)(A.out + (size_t)row * 1024 + col) = *(const f32x4*)(A.in[1] + (size_t)(row - MP) * 1024 + col) + *(const f32x4*)(gate + bi * 1024 + col) * v;
    }
    __syncthreads();
}
#undef MINI_TASKS

#define XB_TMO      128
#define XB_XCNT(j)  (256  + 64 * (j))
#define XB_XSUB(j)  (1280 + 64 * (j))
#define XB_XGEN(j)  (2304 + 64 * (j))
#define XB_TOP      3328
#define XB_TOPGEN   3392
#define XCD_BAR_WORDS 3456
#define XB_SPIN_CAP (1u << 18)

__device__ __forceinline__ unsigned xb_ld(unsigned* p)              { return __hip_atomic_load(p, __ATOMIC_RELAXED, __HIP_MEMORY_SCOPE_AGENT); }
__device__ __forceinline__ unsigned xb_add(unsigned* p, unsigned v) { return __hip_atomic_fetch_add(p, v, __ATOMIC_RELAXED, __HIP_MEMORY_SCOPE_AGENT); }
__device__ __forceinline__ unsigned xb_xcc_id() { return (unsigned)__builtin_amdgcn_s_getreg((3 << 11) | 20) & 0xFu; }
#define XB_SPIN(cond, bar) do { unsigned _sp = 0; while (cond) { __builtin_amdgcn_s_sleep(1); \
    if ((++_sp & 255u) == 0u) { if (xb_ld(&(bar)[XB_TMO])) break; if (_sp > XB_SPIN_CAP) { atomicAdd(&(bar)[XB_TMO], 1u); break; } } } } while (0)

struct XcdBarrier {
    unsigned* bar; unsigned x;
    volatile LAS unsigned* st;
};

__device__ __forceinline__ XcdBarrier xcd_barrier_post(unsigned* bar, volatile LAS unsigned* st) {
    XcdBarrier b; b.bar = bar; b.x = xb_xcc_id(); b.st = st;
    if (threadIdx.x == 0) (void)xb_add(&bar[XB_XCNT(b.x)], 1u);
    return b;
}
__device__ __forceinline__ void xcd_barrier_complete(unsigned* bar, unsigned x, unsigned& nloc, unsigned& nx) {
    const unsigned G = gridDim.x * gridDim.y * gridDim.z;
    unsigned sum, cnt, mine, sp = 0u;
    for (;;) {
        sum = 0u; cnt = 0u; mine = 0u;
#pragma unroll
        for (unsigned j = 0; j < 16; ++j) { const unsigned c = xb_ld(&bar[XB_XCNT(j)]); sum += c; cnt += (c > 0u) ? 1u : 0u; mine = (j == x) ? c : mine; }
        if (sum == G) break;
        __builtin_amdgcn_s_sleep(1);
        if ((++sp & 255u) == 0u) { if (xb_ld(&bar[XB_TMO])) break; if (sp > XB_SPIN_CAP) { atomicAdd(&bar[XB_TMO], 1u); break; } }
    }
    nloc = mine > 0u ? mine : 1u; nx = cnt > 0u ? cnt : 1u;
}

__device__ __forceinline__ void xcd_barrier(const XcdBarrier& b) {
    asm volatile("s_waitcnt vmcnt(0)" ::: "memory");
    __syncthreads();
    if (threadIdx.x == 0) {
        unsigned* bar = b.bar;
        __builtin_amdgcn_s_waitcnt(0);
        unsigned nloc = b.st[0], nx = b.st[1];
        if (nloc == 0u) { xcd_barrier_complete(bar, b.x, nloc, nx); b.st[0] = nloc; b.st[1] = nx; }
        const unsigned old = xb_add(&bar[XB_XSUB(b.x)], 1u);
        const unsigned gen = old / nloc;
        if (old + 1u == (gen + 1u) * nloc) {
            __builtin_amdgcn_fence(__ATOMIC_RELEASE, "agent");
            asm volatile("s_waitcnt vmcnt(0)" ::: "memory");
            const unsigned og = xb_add(&bar[XB_TOP], 1u);
            const unsigned tg = og / nx;
            if (og + 1u == (tg + 1u) * nx) xb_add(&bar[XB_TOPGEN], 1u);
            else XB_SPIN(xb_ld(&bar[XB_TOPGEN]) == tg, bar);
            __builtin_amdgcn_fence(__ATOMIC_ACQUIRE, "agent");
            xb_add(&bar[XB_XGEN(b.x)], 1u);
            asm volatile("s_waitcnt vmcnt(0)" ::: "memory");
        } else {
            XB_SPIN(xb_ld(&bar[XB_XGEN(b.x)]) == gen, bar);
            __builtin_amdgcn_fence(__ATOMIC_ACQUIRE, "agent");
            asm volatile("s_waitcnt vmcnt(0)" ::: "memory");
        }
    }
    __syncthreads();
}

__global__ void __launch_bounds__(512, 2) mk_fwd(Args A) {
    extern __shared__ __attribute__((aligned(16))) unsigned char lds_raw[];
    LAS unsigned char* lds = (LAS unsigned char*)lds_raw;
    cg::grid_group grid = cg::this_grid();
    const int tid = threadIdx.x, lane = tid & 63, wave = __builtin_amdgcn_readfirstlane(tid >> 6);
    const int lo = A.ph_lo, hi = A.ph_hi, G = gridDim.x;
    unsigned char* ws = A.ws;
    if (hi > 1000) grid.sync();
    volatile LAS unsigned* xst = (volatile LAS unsigned*)(lds + LDS_BYTES - 64);
    if (tid < 16) xst[tid] = 0u;
    __syncthreads();
    XcdBarrier xbar; xbar.bar = (unsigned*)(ws + WS_BAR); xbar.x = 0; xbar.st = nullptr;
    if (hi - lo > 1) xbar = xcd_barrier_post((unsigned*)(ws + WS_BAR), xst);
#define IN(k) (lo <= (k) && (k) < hi)
#ifndef REP_SYNC
#define REP_SYNC 1
#endif
#ifndef REP_G1
#define REP_G1 1
#endif
#ifndef REP_AT
#define REP_AT 1
#endif
#ifndef REP_SS
#define REP_SS 1
#endif
#ifndef REP_TAIL
#define REP_TAIL 1
#endif
#define SEAM(k) do { if (IN(k) && (IN((k) + 1) || ((k) == 3 && IN(5)))) { for (int r_ = 0; r_ < REP_SYNC; ++r_) xcd_barrier(xbar); } } while (0)
    #ifndef REP_P0
#define REP_P0 1
#endif
    if (IN(0)) { p0_prep(A, lds, tid, wave, lane); for (int r_ = 1; r_ < REP_P0; ++r_) { __syncthreads(); p0_prep(A, lds, tid, wave, lane, false); } }
    #ifndef REP_P1
#define REP_P1 1
#endif
#ifndef REP_P6
#define REP_P6 1
#endif
#ifndef REP_P7
#define REP_P7 1
#endif
    if (IN(1)) { for (int r_ = 0; r_ < REP_P1; ++r_) p1_hnorm(A, tid, wave, lane); } SEAM(1);
    if (IN(2)) {
        pg8::Gemm g{(const bf16_t*)(ws + WS_H), (const bf16_t*)(ws + WS_WIN), MP, 5120, 1024}; pg8::StaticOrder S; S.init(MP, 5120, G, (int)blockIdx.x);
        Epi1 E{ws, A.out, A.in[12], A.in[13]};
        pg8::gemm_phase<Epi1, pg8::StaticOrder, true, true>(lds, g, S, E);
#if REP_G1 == 2
        pg8::gemm_phase<Epi1, pg8::StaticOrder, true, true>(lds, g, S, E);
#endif
        mini_gemm1(A, lds, wave, lane);
    } SEAM(2);
    if (IN(3)) {
        p3_bias(A, lds, tid);
        if (wave < 4) { p3_attn(A, lds, tid, wave, lane); p3_ssmA(A, lds, wave, lane); }
        else          { p3_ssmA(A, lds, wave, lane); p3_attn(A, lds, tid, wave, lane); }
        p4_ssmC(A, lds, wave, lane);
    } SEAM(3);
    if (IN(5)) {
        pg8::Gemm g{(const bf16_t*)(ws + WS_Y), (const bf16_t*)(ws + WS_WGLU), MP, 1024, 512}; pg8::StaticOrder S; S.init(MP, 1024, G, (int)blockIdx.x);
        EpiGLU E{(const bf16_t*)(ws + WS_GS), (bf16_t*)(ws + WS_XCAT), A.in[24]};
        pg8::gemm_phase<EpiGLU, pg8::StaticOrder, true, true>(lds, g, S, E);
        mini_glu(A, lds, wave, lane);
    } SEAM(5);
    if (IN(6)) {
        mini_branch(A, lds, wave, lane);
        pg8::StaticOrder S; S.init(MP, 1024, G, (int)blockIdx.x);
        pg8::Gemm g{(const bf16_t*)(ws + WS_XCAT), (const bf16_t*)(ws + WS_WCAT), MP, 1024, 1024}; EpiCat E{(bf16_t*)(ws + WS_MERGED), (const bf16_t*)(ws + WS_MA), (const bf16_t*)(ws + WS_MSG)};
        pg8::gemm_phase<EpiCat, pg8::StaticOrder, true, true>(lds, g, S, E);
    } SEAM(6);
    if (IN(7)) {
        pg8::Gemm g{(const bf16_t*)(ws + WS_MERGED), (const bf16_t*)(ws + WS_WOUT), MP, 1024, 1024}; pg8::StaticOrder S; S.init(MP, 1024, G, (int)blockIdx.x);
        EpiOut E{A.in[0], A.in[1], (const float*)(ws + WS_GATE), A.out};
        pg8::gemm_phase<EpiOut, pg8::StaticOrder, true, true>(lds, g, S, E);
        mini_out(A, lds, wave, lane);
#if REP_P7 == 2
        pg8::gemm_phase<EpiOut, pg8::StaticOrder, true, true>(lds, g, S, E);
#endif
    }
#undef IN
#undef SEAM
}

extern "C" void kernel_launch(void* const* d_in, const int* in_sizes, int n_in, void* d_out, int out_size, void* d_ws, size_t ws_size, hipStream_t stream) {
    static int grid = 0;
    if (grid == 0) {
        if (n_in != 28 || (size_t)out_size != OUT_TOTAL || ws_size < WS_END) { fprintf(stderr, "kernel_launch: unexpected shapes n_in %d out %d ws %zu\n", n_in, out_size, ws_size); grid = -1; return; }
        int dev = 0, cus = 0, per_cu = 0;
        hipGetDevice(&dev); hipDeviceGetAttribute(&cus, hipDeviceAttributeMultiprocessorCount, dev);
        if (hipFuncSetAttribute((const void*)mk_fwd, hipFuncAttributeMaxDynamicSharedMemorySize, LDS_BYTES) != hipSuccess) { fprintf(stderr, "kernel_launch: hipFuncSetAttribute failed\n"); grid = -1; return; }
        if (hipOccupancyMaxActiveBlocksPerMultiprocessor(&per_cu, (const void*)mk_fwd, 512, LDS_BYTES) != hipSuccess || per_cu < 1) { fprintf(stderr, "kernel_launch: occupancy query says %d\n", per_cu); (void)hipGetLastError(); per_cu = 1; }
        grid = cus * 1;
        if (grid % 4 != 0) grid -= grid % 4;
    }
    if (grid < 0) return;
    (void)hipMemsetAsync((char*)d_ws + WS_MOD, 0, CTL_ZERO_BYTES, stream);
    Args a{};
    for (int i = 0; i < 28; ++i) a.in[i] = (const float*)d_in[i];
    a.out = (float*)d_out; a.ws = (unsigned char*)d_ws;
#if MK_N_LAUNCHES == 1
    a.ph_lo = 0; a.ph_hi = NPH;
    void* args[] = {&a};
    hipError_t e = hipLaunchCooperativeKernel((const void*)mk_fwd, dim3(grid), dim3(512), args, LDS_BYTES, stream);
    if (e != hipSuccess) fprintf(stderr, "kernel_launch: cooperative launch failed: %s (grid %d)\n", hipGetErrorString(e), grid);
#else
    for (int p = 0; p < NPH; ++p) { a.ph_lo = p; a.ph_hi = p + 1; hipLaunchKernelGGL(mk_fwd, dim3(grid), dim3(512), LDS_BYTES, stream, a); }
#endif
}
```

```cpp
#include <hip/hip_runtime.h>
#include <hip/hip_cooperative_groups.h>
#include <cstdio>
#include <cstdint>
namespace cg = cooperative_groups;
namespace pg8 {
#define PG8_LAS __attribute__((address_space(3)))
typedef unsigned short bf16_t;
typedef short bf16x8 __attribute__((ext_vector_type(8)));
typedef float f32x4 __attribute__((ext_vector_type(4)));
typedef unsigned u32x4 __attribute__((ext_vector_type(4)));
constexpr int BM = 256, BK = 64, HALF = 128, HTB = HALF * BK * 2  , STAGE_BYTES = 8 * HTB, NXCD = 8, WGM = 8;

__host__ __device__ __forceinline__ int lds_byte(int r, int c) { const int st = (r >> 4) * 2 + (c >> 5), rr = r & 15, cc = c & 31, ob = rr * 64 + cc * 2; return st * 1024 + (ob ^ (((ob >> 9) & 1) << 5)); }
__host__ __device__ __forceinline__ void stage_rc(int b, int& R, int& C) { const int st = b / 1024, sb = b % 1024, swz = sb ^ (((sb >> 9) & 1) << 5); R = (st >> 1) * 16 + swz / 64; C = (st & 1) * 32 + (swz % 64) / 2; }
__host__ __device__ __forceinline__ int perm32(int rho) { const int n = rho >> 4, i = rho & 15; return 8 * (i >> 2) + 4 * n + (i & 3); }

struct Unit { int pm, pn; };
struct Gemm { const bf16_t* A; const bf16_t* Bt; int M, N, K; };

struct StaticOrder {
    int nM, nN, nwg, G, c;
    __host__ __device__ void init(int M, int N, int G_, int c_) { nM = M / BM; nN = N / BM; nwg = nM * nN; G = G_; c = c_; }
    __host__ __device__ bool next(int i, Unit& u) const {
        const long L = (long)i * G + c; if (L >= nwg) return false;
        int wgid = (int)L; { const int q = nwg / NXCD, r = nwg % NXCD, xcd = wgid % NXCD, off = wgid / NXCD; wgid = (xcd < r ? xcd * (q + 1) : r * (q + 1) + (xcd - r) * q) + off; }
        const int nig = WGM * nN, gid = wgid / nig, fm = gid * WGM, gsz = (nM - fm) < WGM ? (nM - fm) : WGM;
        u.pm = fm + ((wgid % nig) % gsz); u.pn = (wgid % nig) / gsz; return true;
    }
    __device__ __forceinline__ void a_ready(const Unit&) const {}
    __device__ __forceinline__ void done(const Unit&) const {}
};

__device__ __forceinline__ unsigned cvt_pk_bf16(float lo, float hi) { unsigned r; asm volatile("v_cvt_pk_bf16_f32 %0, %1, %2" : "=v"(r) : "v"(lo), "v"(hi)); return r; }
template <class Epi, class Sched, bool ALIGN_EPI = false, bool SP2 = false>
__device__ __forceinline__ void gemm_phase(PG8_LAS unsigned char* lds, const Gemm g, const Sched& S, const Epi& E) {
    const int tid = threadIdx.x, wid = __builtin_amdgcn_readfirstlane(tid >> 6), lane = tid & 63, wr = wid >> 2, wc = wid & 3, fr = lane & 15, fq = lane >> 4;
    const int K = g.K, nt = K / BK;
    unsigned voffA[2], voffB[2];
#pragma unroll
    for (int i = 0; i < 2; ++i) { int R, C; stage_rc(tid * 16 + i * 8192, R, C); const int Rb = Epi::PERM ? ((R & ~31) + perm32(R & 31)) : R;
        voffA[i] = (unsigned)(R * K + C) * 2u; voffB[i] = (unsigned)(Rb * K + C) * 2u; }
    const size_t kstep = (size_t)(BK * 2);
    const size_t hstep = (size_t)HALF * K * 2;
    const size_t tstep = 2 * hstep;
    const unsigned ldsw = (unsigned)wid * 1024u;
    const int aoff = lds_byte(wr * 64 + fr, fq * 8), boff = lds_byte(wc * 32 + fr, fq * 8);
#define PG8_SA(b, h) (((b) * 2 + (h)) * HTB)
#define PG8_SB(b, h) ((4 + (b) * 2 + (h)) * HTB)
#define PG8_STAGE(bufoff, gbase, voff) do { _Pragma("unroll") for (int _i = 0; _i < 2; ++_i) \
        __builtin_amdgcn_global_load_lds((const unsigned*)((const char*)(gbase) + (voff)[_i]), (PG8_LAS unsigned*)(lds + (bufoff) + ldsw + _i * 8192), 16, 0, 0); } while (0)
#define PG8_LDA(dst, b, h) do { _Pragma("unroll") for (int m = 0; m < 4; ++m) _Pragma("unroll") for (int k = 0; k < 2; ++k) dst[m][k] = *(const PG8_LAS bf16x8*)(lds + PG8_SA(b, h) + aoff + m * 2048 + k * 1024); } while (0)
#define PG8_LDB(dst, b, h) do { _Pragma("unroll") for (int n = 0; n < 2; ++n) _Pragma("unroll") for (int k = 0; k < 2; ++k) dst[n][k] = *(const PG8_LAS bf16x8*)(lds + PG8_SB(b, h) + boff + n * 2048 + k * 1024); } while (0)
#define PG8_MMA(ai, bj, At, Bt) do { __builtin_amdgcn_s_setprio(1); _Pragma("unroll") for (int m = 0; m < 4; ++m) _Pragma("unroll") for (int n = 0; n < 2; ++n) _Pragma("unroll") for (int k = 0; k < 2; ++k) \
        acc[ai][bj][m][n] = __builtin_amdgcn_mfma_f32_16x16x32_bf16(Bt[n][k], At[m][k], acc[ai][bj][m][n], 0, 0, 0); __builtin_amdgcn_s_setprio(0); } while (0)
#define PG8_WAIT_V(n) asm volatile("s_waitcnt vmcnt(" #n ")" ::: "memory")
#define PG8_WAIT_L(n) asm volatile("s_waitcnt lgkmcnt(" #n ")" ::: "memory")
#define PG8_BAR __builtin_amdgcn_s_barrier()
#define PG8_SCHED __builtin_amdgcn_sched_barrier(0)
    Unit cur, nxt; int ui = 0;
    if (!S.next(0, cur)) return;
    f32x4 acc[2][2][4][2];
#pragma unroll
    for (int a = 0; a < 2; ++a)
#pragma unroll
        for (int b = 0; b < 2; ++b)
#pragma unroll
            for (int m = 0; m < 4; ++m)
#pragma unroll
                for (int n = 0; n < 2; ++n) acc[a][b][m][n] = (f32x4){0.f, 0.f, 0.f, 0.f};
    bf16x8 At[4][2], B0[2][2], B1[2][2];
    const char* cA = (const char*)g.A + (size_t)cur.pm * tstep; const char* cB = (const char*)g.Bt + (size_t)cur.pn * tstep;
    S.a_ready(cur);
    if constexpr (SP2) {
        PG8_STAGE(PG8_SB(0, 0), cB, voffB); PG8_STAGE(PG8_SB(0, 1), cB + hstep, voffB); PG8_STAGE(PG8_SA(0, 0), cA, voffA); PG8_STAGE(PG8_SA(0, 1), cA + hstep, voffA);
        if (wr == 1) PG8_BAR;
        PG8_WAIT_V(2); PG8_BAR;
        PG8_STAGE(PG8_SB(1, 0), cB + kstep, voffB); PG8_STAGE(PG8_SA(1, 0), cA + kstep, voffA); PG8_STAGE(PG8_SB(1, 1), cB + hstep + kstep, voffB);
        PG8_WAIT_V(6); PG8_BAR;
    } else {
        PG8_STAGE(PG8_SB(0, 0), cB, voffB); PG8_STAGE(PG8_SA(0, 0), cA, voffA); PG8_STAGE(PG8_SB(0, 1), cB + hstep, voffB); PG8_STAGE(PG8_SA(0, 1), cA + hstep, voffA);
        if (wr == 1) PG8_BAR;
        PG8_WAIT_V(4); PG8_BAR;
        PG8_STAGE(PG8_SB(1, 0), cB + kstep, voffB); PG8_STAGE(PG8_SA(1, 0), cA + kstep, voffA); PG8_STAGE(PG8_SB(1, 1), cB + hstep + kstep, voffB);
        PG8_WAIT_V(6); PG8_BAR;
    }
    for (;;) {
        const bool has_next = S.next(ui + 1, nxt);
        const char* nA = has_next ? (const char*)g.A + (size_t)nxt.pm * tstep : cA; const char* nB = has_next ? (const char*)g.Bt + (size_t)nxt.pn * tstep : cB;
        for (int t = 0; t < nt; t += 2) {
            if constexpr (Epi::HAS_MID) { if (t == Epi::MID_T) E.mid(acc, cur, wr, wc, fr, fq); }
            const bool last = (t == nt - 2);
            const char* a1 = cA + (size_t)(t + 1) * kstep;
            const char* a2 = last ? nA : cA + (size_t)(t + 2) * kstep; const char* b2 = last ? nB : cB + (size_t)(t + 2) * kstep;
            const char* a3 = a2 + kstep; const char* b3 = b2 + kstep;
            if (last && has_next) S.a_ready(nxt);
            if constexpr (SP2) {
            PG8_LDB(B0, 0, 0); PG8_LDB(B1, 0, 1); PG8_SCHED; PG8_LDA(At, 0, 0); PG8_STAGE(PG8_SA(1, 1), a1 + hstep, voffA);
            PG8_WAIT_V(8); PG8_WAIT_L(0); PG8_BAR; PG8_MMA(0, 0, At, B0); PG8_MMA(0, 1, At, B1); PG8_BAR; PG8_SCHED;
            PG8_LDA(At, 0, 1); PG8_STAGE(PG8_SB(0, 0), b2, voffB); PG8_STAGE(PG8_SB(0, 1), b2 + hstep, voffB); PG8_STAGE(PG8_SA(0, 0), a2, voffA);
            PG8_WAIT_V(8); PG8_WAIT_L(0); PG8_BAR; PG8_MMA(1, 0, At, B0); PG8_MMA(1, 1, At, B1); PG8_BAR; PG8_SCHED;
            PG8_LDB(B0, 1, 0); PG8_LDB(B1, 1, 1); PG8_SCHED; PG8_LDA(At, 1, 0); PG8_STAGE(PG8_SA(0, 1), a2 + hstep, voffA);
            PG8_WAIT_V(8); PG8_WAIT_L(0); PG8_BAR; PG8_MMA(0, 0, At, B0); PG8_MMA(0, 1, At, B1); PG8_BAR; PG8_SCHED;
            PG8_LDA(At, 1, 1); PG8_STAGE(PG8_SB(1, 0), b3, voffB); PG8_STAGE(PG8_SB(1, 1), b3 + hstep, voffB); PG8_STAGE(PG8_SA(1, 0), a3, voffA);
            PG8_WAIT_V(8); PG8_WAIT_L(0); PG8_BAR; PG8_MMA(1, 0, At, B0); PG8_MMA(1, 1, At, B1); PG8_BAR; PG8_SCHED;
            } else {
            PG8_LDB(B0, 0, 0); PG8_SCHED; PG8_LDA(At, 0, 0); PG8_STAGE(PG8_SA(1, 1), a1 + hstep, voffA);
            PG8_WAIT_L(8); PG8_BAR; PG8_WAIT_L(0); PG8_MMA(0, 0, At, B0); PG8_BAR; PG8_SCHED;
            PG8_LDB(B1, 0, 1); PG8_STAGE(PG8_SB(0, 0), b2, voffB);
            PG8_BAR; PG8_WAIT_L(0); PG8_MMA(0, 1, At, B1); PG8_BAR;
            PG8_LDA(At, 0, 1); PG8_STAGE(PG8_SA(0, 0), a2, voffA);
            PG8_BAR; PG8_WAIT_L(0); PG8_MMA(1, 0, At, B0); PG8_BAR; PG8_SCHED;
            PG8_STAGE(PG8_SB(0, 1), b2 + hstep, voffB);
            PG8_WAIT_V(6); PG8_BAR; PG8_MMA(1, 1, At, B1); PG8_BAR;
            PG8_LDB(B0, 1, 0); PG8_SCHED; PG8_LDA(At, 1, 0); PG8_STAGE(PG8_SA(0, 1), a2 + hstep, voffA);
            PG8_WAIT_L(8); PG8_BAR; PG8_WAIT_L(0); PG8_MMA(0, 0, At, B0); PG8_BAR; PG8_SCHED;
            PG8_LDB(B1, 1, 1); PG8_STAGE(PG8_SB(1, 0), b3, voffB);
            PG8_BAR; PG8_WAIT_L(0); PG8_MMA(0, 1, At, B1); PG8_BAR;
            PG8_LDA(At, 1, 1); PG8_STAGE(PG8_SA(1, 0), a3, voffA);
            PG8_BAR; PG8_WAIT_L(0); PG8_MMA(1, 0, At, B0); PG8_BAR; PG8_SCHED;
            PG8_STAGE(PG8_SB(1, 1), b3 + hstep, voffB);
            PG8_WAIT_V(6); PG8_BAR; PG8_MMA(1, 1, At, B1); PG8_BAR;
            }
        }
        if constexpr (ALIGN_EPI) { if (wr == 0) PG8_BAR; }
        if constexpr (!Epi::AFTER_DRAIN) { E(acc, cur, wr, wc, fr, fq); S.done(cur); }
        if (!has_next) break;
#pragma unroll
        for (int a = 0; a < 2; ++a)
#pragma unroll
            for (int b = 0; b < 2; ++b)
#pragma unroll
                for (int m = 0; m < 4; ++m)
#pragma unroll
                    for (int n = 0; n < 2; ++n) acc[a][b][m][n] = (f32x4){0.f, 0.f, 0.f, 0.f};
        cur = nxt; cA = nA; cB = nB; ++ui;
        if constexpr (ALIGN_EPI) { if (wr == 1) PG8_BAR; }
    }
    PG8_WAIT_V(0);
    if constexpr (!ALIGN_EPI) { if (wr == 0) PG8_BAR; }
    PG8_BAR;
    if constexpr (Epi::AFTER_DRAIN) { E.fused(acc, cur, wr, wc, fr, fq, lds, wid, lane); S.done(cur); }
#undef PG8_SA
#undef PG8_SB
#undef PG8_STAGE
#undef PG8_LDA
#undef PG8_LDB
#undef PG8_MMA
#undef PG8_WAIT_V
#undef PG8_WAIT_L
#undef PG8_BAR
#undef PG8_SCHED
}
}

#define DI __device__ __forceinline__
#define LAS __attribute__((address_space(3)))
using pg8::bf16_t; using pg8::bf16x8; using pg8::f32x4; using pg8::u32x4;
typedef float f32x2 __attribute__((ext_vector_type(2)));
typedef float f32x16 __attribute__((ext_vector_type(16)));
typedef unsigned u32x2 __attribute__((ext_vector_type(2)));
typedef __bf16 bf16x2v __attribute__((ext_vector_type(2)));

constexpr int MP = 16384, MT = 16640;
constexpr float LOG2E = 1.4426950408889634f, RMS_EPS = 1e-6f;
constexpr size_t MiB = 1u << 20;
constexpr size_t WS_MOD = 0, MOD_BYTES = 18 * 3072 * 4, CTL_ZERO_BYTES = 256 * 1024;
constexpr size_t WS_BAR = 240 * 1024;
constexpr size_t WS_GATE = 256 * 1024;
constexpr size_t WS_SSM = 1 * MiB;
constexpr size_t SSM_AR = WS_SSM, SSM_AI = SSM_AR + 8192, SSM_ALR = SSM_AI + 8192, SSM_ALI = SSM_ALR + 8192, SSM_BB = SSM_ALI + 8192  , SSM_CB = SSM_BB + 262144  ;
constexpr size_t WS_WIN = 2 * MiB, WS_WGLU = 12 * MiB, WS_WCAT = 13 * MiB  , WS_WOUT = 15 * MiB;
constexpr size_t WS_E = 17 * MiB;
constexpr size_t WS_KSF = 21 * MiB, WS_VSF = 30 * MiB;
constexpr size_t WS_H = 40 * MiB, WS_XCAT = 40 * MiB  , WS_Y = 156 * MiB + 512 * 1024;
constexpr size_t WS_QF = 73 * MiB, WS_KF = 90 * MiB, WS_VF = 107 * MiB, WS_MERGED = 73 * MiB;
constexpr size_t WS_GA = 123 * MiB, WS_U = 140 * MiB, WS_GS = 173 * MiB, WS_MA = 190 * MiB, WS_MSG = 223 * MiB, WS_END = 256 * MiB;
constexpr size_t O1 = 16777216, O2 = 17039360, O3 = 17563648, O4 = 18087936, O5 = 18092032, O6 = 18096128, O7 = 18227200, O8 = 18358272, O9 = 18391040, OUT_TOTAL = 18423808;
constexpr int LDS_BYTES = 163840, BIAS_OFF = 135168;
constexpr int NPH = 8;
#ifndef MK_N_LAUNCHES
#define MK_N_LAUNCHES 1
#endif

DI unsigned pk(float a, float b) { f32x2 v = {a, b}; bf16x2v r = __builtin_convertvector(v, bf16x2v); return __builtin_bit_cast(unsigned, r); }
DI float bflo(unsigned w) { return __uint_as_float(w << 16); }
DI float bfhi(unsigned w) { return __uint_as_float(w & 0xffff0000u); }
DI float ex2(float x) { return __builtin_amdgcn_exp2f(x); }
DI float sigm(float x) { return __builtin_amdgcn_rcpf(1.f + ex2(-x * LOG2E)); }
DI float silu(float x) { return x * sigm(x); }
DI u32x4 pk8(f32x4 a, f32x4 b) { u32x4 w; w.x = pk(a.x, a.y); w.y = pk(a.z, a.w); w.z = pk(b.x, b.y); w.w = pk(b.z, b.w); return w; }
#define MFMA32(a, b, c) __builtin_amdgcn_mfma_f32_32x32x16_bf16((a), (b), (c), 0, 0, 0)
#define MFMA16(a, b, c) __builtin_amdgcn_mfma_f32_16x16x32_bf16((a), (b), (c), 0, 0, 0)
#define LDS_WAIT() asm volatile("s_waitcnt lgkmcnt(0)" ::: "memory")

struct Args { const float* in[28]; float* out; unsigned char* ws; int ph_lo, ph_hi; };

DI int phys_std(int n) { return (n & ~255) | (((n >> 5) & 1) << 7) | (((n >> 6) & 3) << 5) | (n & 31); }
DI int phys_glu(int n) { const int half = n >> 9, j = n & 511; return ((j >> 7) << 8) | (half << 7) | (j & 127); }

struct Epi1 {
    static constexpr bool PERM = true, AFTER_DRAIN = false, HAS_MID = false;
    unsigned char* ws; float* out; const float* qg; const float* kg;
    DI void operator()(const f32x4 (&acc)[2][2][4][2], const pg8::Unit& u, int wr, int wc, int fr, int fq) const {
        const int pn = u.pn; const bool samp = (u.pm == 64);
        const int rbase = u.pm * 256 + wr * 64 + fr;
        if (pn < 4) {
            const bool isk = pn >= 2; const int head = (pn & 1) * 4 + wc;
            const float* gp = isk ? kg : qg; const float sc = isk ? 1.f : 0.125f * LOG2E;
            f32x4 gv[2][2];
#pragma unroll
            for (int bj = 0; bj < 2; ++bj)
#pragma unroll
                for (int n = 0; n < 2; ++n) gv[bj][n] = *(const f32x4*)(gp + 32 * bj + 8 * fq + 4 * n);
#pragma unroll
            for (int ai = 0; ai < 2; ++ai)
#pragma unroll
                for (int m = 0; m < 4; ++m) {
                    float ss = 0.f;
#pragma unroll
                    for (int bj = 0; bj < 2; ++bj)
#pragma unroll
                        for (int n = 0; n < 2; ++n) { const f32x4 x = acc[ai][bj][m][n]; ss += (x.x * x.x + x.y * x.y) + (x.z * x.z + x.w * x.w); }
                    ss += __shfl_xor(ss, 16); ss += __shfl_xor(ss, 32);
                    const float rs = (1.0f / sqrtf(ss * (1.f / 64.f) + RMS_EPS)) * sc;
                    const int row = rbase + ai * 128 + m * 16;
                    int b, t; if (samp) { b = (row - MP) >> 4; t = row & 15; } else { b = row >> 13; t = row & 8191; }
#pragma unroll
                    for (int bj = 0; bj < 2; ++bj) {
                        const f32x4 v0 = acc[ai][bj][m][0] * gv[bj][0] * rs, v1 = acc[ai][bj][m][1] * gv[bj][1] * rs;
                        const u32x4 w = pk8(v0, v1);
                        const int kk = 2 * bj + (fq >> 1), hi = fq & 1;
                        if (!isk) {
                            bf16_t* QF = (bf16_t*)(ws + WS_QF);
                            *(u32x4*)(QF + ((size_t)(row >> 5) * 8 + head) * 2048 + (kk * 64 + (row & 31) + 32 * hi) * 8) = w;
                        } else {
                            const int d0 = 32 * bj + 8 * fq;
                            if (samp) {
                                bf16_t* KSF = (bf16_t*)(ws + WS_KSF);
                                *(u32x4*)(KSF + ((size_t)(b * 8 + head) * 9 + 8) * 4096 + (kk * 64 + t + 32 * hi) * 8) = w;
                                float* o = out + O6 + ((size_t)(b * 16 + t) * 8 + head) * 64 + d0; *(f32x4*)o = v0; *(f32x4*)(o + 4) = v1;
                            } else {
                                bf16_t* KF = (bf16_t*)(ws + WS_KF); const int k64 = t & 63;
                                *(u32x4*)(KF + ((size_t)(b * 8 + head) * 128 + (t >> 6)) * 4096 + (((k64 >> 5) * 4 + kk) * 64 + (k64 & 31) + 32 * hi) * 8) = w;
                                if (t >= 7680) { float* o = out + O2 + ((size_t)(b * 512 + t - 7680) * 8 + head) * 64 + d0; *(f32x4*)o = v0; *(f32x4*)(o + 4) = v1; }
                            }
                        }
                    }
                }
        } else if (pn < 6) {
            const int head = (pn & 1) * 4 + wc;
#pragma unroll
            for (int ai = 0; ai < 2; ++ai)
#pragma unroll
                for (int m = 0; m < 4; ++m) {
                    const int row = rbase + ai * 128 + m * 16;
                    int b, t, k64; bf16_t* tb;
                    if (samp) { b = (row - MP) >> 4; t = row & 15; k64 = t; tb = (bf16_t*)(ws + WS_VSF) + ((size_t)(b * 8 + head) * 9 + 8) * 4096; }
                    else { b = row >> 13; t = row & 8191; k64 = t & 63; tb = (bf16_t*)(ws + WS_VF) + ((size_t)(b * 8 + head) * 128 + (t >> 6)) * 4096; }
                    const int kh = k64 >> 5, half = (k64 >> 4) & 1, k16 = k64 & 15, hik = (k16 >> 2) & 1, jk = (k16 & 3) + 4 * (k16 >> 3);
#pragma unroll
                    for (int bj = 0; bj < 2; ++bj) {
                        bf16_t* dst = tb + ((((kh * 2 + half) * 2 + bj) * 64) + 8 * fq + 32 * hik) * 8 + jk;
                        const f32x4 v0 = acc[ai][bj][m][0], v1 = acc[ai][bj][m][1];
                        const unsigned w0 = pk(v0.x, v0.y), w1 = pk(v0.z, v0.w), w2 = pk(v1.x, v1.y), w3 = pk(v1.z, v1.w);
                        dst[0] = (bf16_t)w0; dst[8] = (bf16_t)(w0 >> 16); dst[16] = (bf16_t)w1; dst[24] = (bf16_t)(w1 >> 16);
                        dst[32] = (bf16_t)w2; dst[40] = (bf16_t)(w2 >> 16); dst[48] = (bf16_t)w3; dst[56] = (bf16_t)(w3 >> 16);
                        const int d0 = 32 * bj + 8 * fq;
                        if (samp) { float* o = out + O7 + ((size_t)(b * 16 + t) * 8 + head) * 64 + d0; *(f32x4*)o = v0; *(f32x4*)(o + 4) = v1; }
                        else if (t >= 7680) { float* o = out + O3 + ((size_t)(b * 512 + t - 7680) * 8 + head) * 64 + d0; *(f32x4*)o = v0; *(f32x4*)(o + 4) = v1; }
                    }
                }
        } else if (pn >= 8 && pn < 10) {
            bf16_t* U = (bf16_t*)(ws + WS_U);
#pragma unroll
            for (int ai = 0; ai < 2; ++ai)
#pragma unroll
                for (int m = 0; m < 4; ++m) {
                    const int row = rbase + ai * 128 + m * 16;
#pragma unroll
                    for (int bj = 0; bj < 2; ++bj) *(u32x4*)(U + (size_t)row * 512 + (pn - 8) * 256 + 64 * wc + 32 * bj + 8 * fq) = pk8(acc[ai][bj][m][0], acc[ai][bj][m][1]);
                }
        } else {
            bf16_t* base; int ld, c0; bool sil;
            if (pn < 8) { base = (bf16_t*)(ws + WS_GA); ld = 512; c0 = (pn - 6) * 256; sil = true; }
            else if (pn < 12) { base = (bf16_t*)(ws + WS_GS); ld = 512; c0 = (pn - 10) * 256; sil = true; }
            else if (pn < 16) { base = (bf16_t*)(ws + WS_MA); ld = 1024; c0 = (pn - 12) * 256; sil = false; }
            else { base = (bf16_t*)(ws + WS_MSG); ld = 1024; c0 = (pn - 16) * 256; sil = false; }
#pragma unroll
            for (int ai = 0; ai < 2; ++ai)
#pragma unroll
                for (int m = 0; m < 4; ++m) {
                    const int row = rbase + ai * 128 + m * 16;
#pragma unroll
                    for (int bj = 0; bj < 2; ++bj) {
                        f32x4 v0 = acc[ai][bj][m][0], v1 = acc[ai][bj][m][1];
#pragma unroll
                        for (int j = 0; j < 4; ++j) { const float s0 = sigm(v0[j]), s1 = sigm(v1[j]); v0[j] = sil ? v0[j] * s0 : s0; v1[j] = sil ? v1[j] * s1 : s1; }
                        *(u32x4*)(base + (size_t)row * ld + c0 + 64 * wc + 32 * bj + 8 * fq) = pk8(v0, v1);
                    }
                }
        }
    }
};

struct EpiGLU {
    static constexpr bool PERM = true, AFTER_DRAIN = false;
    static constexpr bool HAS_MID = false;
    const bf16_t* GSb; bf16_t* XC; const float* bglu;
    DI void operator()(const f32x4 (&acc)[2][2][4][2], const pg8::Unit& u, int wr, int wc, int fr, int fq) const {
        const int col = 128 * u.pn + 32 * wc + 8 * fq, rbase = u.pm * 256 + wr * 64 + fr;
        const f32x4 ba0 = *(const f32x4*)(bglu + col), ba1 = *(const f32x4*)(bglu + col + 4), bb0 = *(const f32x4*)(bglu + 512 + col), bb1 = *(const f32x4*)(bglu + 512 + col + 4);
#pragma unroll
        for (int ai = 0; ai < 2; ++ai)
#pragma unroll
            for (int m = 0; m < 4; ++m) {
                const int row = rbase + ai * 128 + m * 16;
                const u32x4 g = *(const u32x4*)(GSb + (size_t)row * 512 + col);
                f32x4 a0 = acc[ai][0][m][0] + ba0, a1 = acc[ai][0][m][1] + ba1; const f32x4 b0 = acc[ai][1][m][0] + bb0, b1 = acc[ai][1][m][1] + bb1;
#pragma unroll
                for (int j = 0; j < 4; ++j) { a0[j] *= sigm(b0[j]); a1[j] *= sigm(b1[j]); }
                a0.x *= bflo(g.x); a0.y *= bfhi(g.x); a0.z *= bflo(g.y); a0.w *= bfhi(g.y); a1.x *= bflo(g.z); a1.y *= bfhi(g.z); a1.z *= bflo(g.w); a1.w *= bfhi(g.w);
                *(u32x4*)(XC + (size_t)row * 1024 + 512 + col) = pk8(a0, a1);
            }
    }
};

struct EpiCat {
    static constexpr bool PERM = true, AFTER_DRAIN = false, HAS_MID = true; static constexpr int MID_T = 8;
    bf16_t* MG; const bf16_t* GA_; const bf16_t* GS_;
    DI void mid(f32x4 (&acc)[2][2][4][2], const pg8::Unit& u, int wr, int wc, int fr, int fq) const {
        int rbase = u.pm * 256 + wr * 64 + fr;
        asm volatile("" : "+v"(rbase));
#pragma unroll
        for (int ai = 0; ai < 2; ++ai)
#pragma unroll
            for (int m = 0; m < 4; ++m) {
                const int row = rbase + ai * 128 + m * 16;
#pragma unroll
                for (int bj = 0; bj < 2; ++bj) {
                    const size_t off = (size_t)row * 1024 + 256 * u.pn + 64 * wc + 32 * bj + 8 * fq;
                    const u32x4 a = *(const u32x4*)(GA_ + off), c = *(const u32x4*)(GS_ + off);
                    f32x4& v0 = acc[ai][bj][m][0]; f32x4& v1 = acc[ai][bj][m][1];
                    v0.x *= bflo(a.x) * __builtin_amdgcn_rcpf(bflo(c.x)); v0.y *= bfhi(a.x) * __builtin_amdgcn_rcpf(bfhi(c.x)); v0.z *= bflo(a.y) * __builtin_amdgcn_rcpf(bflo(c.y)); v0.w *= bfhi(a.y) * __builtin_amdgcn_rcpf(bfhi(c.y));
                    v1.x *= bflo(a.z) * __builtin_amdgcn_rcpf(bflo(c.z)); v1.y *= bfhi(a.z) * __builtin_amdgcn_rcpf(bfhi(c.z)); v1.z *= bflo(a.w) * __builtin_amdgcn_rcpf(bflo(c.w)); v1.w *= bfhi(a.w) * __builtin_amdgcn_rcpf(bfhi(c.w));
                    asm volatile("" ::: "memory");
                }
            }
    }
    DI void operator()(const f32x4 (&acc)[2][2][4][2], const pg8::Unit& u, int wr, int wc, int fr, int fq) const {
        const int rbase = u.pm * 256 + wr * 64 + fr;
#pragma unroll
        for (int ai = 0; ai < 2; ++ai)
#pragma unroll
            for (int m = 0; m < 4; ++m) {
                const int row = rbase + ai * 128 + m * 16;
#pragma unroll
                for (int bj = 0; bj < 2; ++bj) {
                    const size_t off = (size_t)row * 1024 + 256 * u.pn + 64 * wc + 32 * bj + 8 * fq;
                    const u32x4 g = *(const u32x4*)(GS_ + off);
                    f32x4 v0 = acc[ai][bj][m][0], v1 = acc[ai][bj][m][1];
                    v0.x *= bflo(g.x); v0.y *= bfhi(g.x); v0.z *= bflo(g.y); v0.w *= bfhi(g.y); v1.x *= bflo(g.z); v1.y *= bfhi(g.z); v1.z *= bflo(g.w); v1.w *= bfhi(g.w);
                    *(u32x4*)(MG + off) = pk8(v0, v1);
                }
                asm volatile("" ::: "memory");
            }
    }
};

struct EpiOut {
    static constexpr bool PERM = true, AFTER_DRAIN = false, HAS_MID = false;
    const float* xp; const float* xs; const float* gate; float* out;
    DI void operator()(const f32x4 (&acc)[2][2][4][2], const pg8::Unit& u, int wr, int wc, int fr, int fq) const {
        const int rbase = u.pm * 256 + wr * 64 + fr; const bool samp = (u.pm == 64);
#pragma unroll
        for (int ai = 0; ai < 2; ++ai)
#pragma unroll
            for (int m = 0; m < 4; ++m) {
                const int row = rbase + ai * 128 + m * 16;
                const float* xr = samp ? xs + (size_t)(row - MP) * 1024 : xp + (size_t)row * 1024;
                const int bi = samp ? 2 + ((row - MP) >> 4) : (row >> 13);
#pragma unroll
                for (int bj = 0; bj < 2; ++bj) {
                    const int col = 256 * u.pn + 64 * wc + 32 * bj + 8 * fq;
                    const f32x4 x0 = __builtin_nontemporal_load((const f32x4*)(xr + col)), x1 = __builtin_nontemporal_load((const f32x4*)(xr + col + 4));
                    const f32x4 g0 = *(const f32x4*)(gate + bi * 1024 + col), g1 = *(const f32x4*)(gate + bi * 1024 + col + 4);
                    float* o = out + (size_t)row * 1024 + col;
                    *(f32x4*)o = x0 + g0 * acc[ai][bj][m][0]; *(f32x4*)(o + 4) = x1 + g1 * acc[ai][bj][m][1];
                }
                asm volatile("" ::: "memory");
            }
    }
};

template <int MODE> DI void p0_transpose_item(const float* W, int K, int N, bf16_t* WT, LAS float* scr, int item, int lane, int ldk = 0, int koff = 0) {
    if (ldk == 0) ldk = K;
    const int nblk = N / 32, kb = item / nblk, nb = item % nblk, k0 = 64 * kb, n0 = 32 * nb;
#pragma unroll 8
    for (int i = 0; i < 32; ++i) { const int kk = 2 * i + (lane >> 5); scr[kk * 33 + (lane & 31)] = __builtin_nontemporal_load(W + (size_t)(k0 + kk) * N + n0 + (lane & 31)); }
    LDS_WAIT();
    const int c = lane & 7, prow = MODE ? phys_glu(n0) : phys_std(n0);
#pragma unroll
    for (int j = 0; j < 4; ++j) { const int n = (lane >> 3) + 8 * j; const LAS float* s = scr + (8 * c) * 33 + n;
        u32x4 o; o.x = pk(s[0 * 33], s[1 * 33]); o.y = pk(s[2 * 33], s[3 * 33]); o.z = pk(s[4 * 33], s[5 * 33]); o.w = pk(s[6 * 33], s[7 * 33]);
        *(u32x4*)(WT + (size_t)(prow + n) * ldk + koff + k0 + 8 * c) = o; }
    LDS_WAIT();
}
constexpr int MODCNT_WORD = (255 * 1024) / 4;
DI void p0_mod_item(const float* cp, const float* cs, const float* w_ada, float* MOD, LAS float* scr, int item, int lane) {
    const int cgp = item % 48, ks = item / 48, col0 = 64 * cgp, k0 = 64 * ks;
#pragma unroll
    for (int r = 0; r < 18; ++r) { const float cv = (r < 2) ? cp[r * 1024 + k0 + lane] : cs[(r - 2) * 1024 + k0 + lane]; scr[lane * 20 + r] = silu(cv); }
    scr[lane * 20 + 18] = 0.f; scr[lane * 20 + 19] = 0.f;
    LDS_WAIT();
    f32x4 a[5];
#pragma unroll
    for (int q = 0; q < 5; ++q) a[q] = (f32x4){0.f, 0.f, 0.f, 0.f};
#pragma unroll 8
    for (int kk = 0; kk < 64; ++kk) { const float w = __builtin_nontemporal_load(w_ada + (size_t)(k0 + kk) * 3072 + col0 + lane);
#pragma unroll
        for (int q = 0; q < 5; ++q) { const f32x4 s = *(const LAS f32x4*)(scr + kk * 20 + 4 * q); a[q] += s * w; } }
#pragma unroll
    for (int r = 0; r < 18; ++r) atomicAdd(MOD + r * 3072 + col0 + lane, a[r >> 2][r & 3]);
    asm volatile("s_waitcnt vmcnt(0)" ::: "memory");
    if (lane == 0) __hip_atomic_fetch_add((unsigned*)MOD + MODCNT_WORD, 1u, __ATOMIC_RELAXED, __HIP_MEMORY_SCOPE_AGENT);
    LDS_WAIT();
}
DI void p0_prep(const Args& A, LAS unsigned char* lds, int tid, int wave, int lane, bool do_mod = true) {
    unsigned char* ws = A.ws;
    LAS float* scr = (LAS float*)(lds + wave * 16384);
    const int gw = blockIdx.x * 8 + wave, NGW = gridDim.x * 8, gtid = blockIdx.x * 512 + tid, NT = gridDim.x * 512;
    if (do_mod) for (int it = wave * (int)gridDim.x + (int)blockIdx.x; it < 768; it += NGW) p0_mod_item(A.in[2], A.in[3], A.in[9], (float*)(ws + WS_MOD), scr, it, lane);
#ifdef REP_MOD
    if (do_mod) for (int it = gw; it < 768; it += NGW) p0_mod_item(A.in[2], A.in[3], A.in[9], (float*)(ws + 39 * MiB), scr, it, lane);
#endif
    constexpr int I_IN = 16 * 160, I_G = 8 * 32, I_O = 8 * 32, I_W = 16 * 32;
    for (int it = (wave >= 3) ? (int)blockIdx.x * 5 + (wave - 3) : I_IN + I_G + 2 * I_O + I_W; it < I_IN + I_G + 2 * I_O + I_W; it += (int)gridDim.x * 5) {
        int r = it;
        if (r < I_IN) { p0_transpose_item<0>(A.in[11], 1024, 5120, (bf16_t*)(ws + WS_WIN), scr, r, lane); continue; } r -= I_IN;
        if (r < I_G) { p0_transpose_item<1>(A.in[23], 512, 1024, (bf16_t*)(ws + WS_WGLU), scr, r, lane); continue; } r -= I_G;
        if (r < I_O) { p0_transpose_item<0>(A.in[25], 512, 1024, (bf16_t*)(ws + WS_WCAT), scr, r, lane, 1024, 0); continue; } r -= I_O;
        if (r < I_O) { p0_transpose_item<0>(A.in[26], 512, 1024, (bf16_t*)(ws + WS_WCAT), scr, r, lane, 1024, 512); continue; } r -= I_O;
        p0_transpose_item<0>(A.in[27], 1024, 1024, (bf16_t*)(ws + WS_WOUT), scr, r, lane);
    }
    if (wave == 7 && blockIdx.x < 32) {
        const int g = blockIdx.x, gtid = g * 64 + lane;
        const float lr = A.in[15][gtid], li = A.in[16][gtid], dt = expf(A.in[17][g]);
        const float mag = expf(lr * dt); float sn, cs; sincosf(li * dt, &sn, &cs);
        const float ar = mag * cs, ai = mag * sn, den = lr * lr + li * li, nr = ar - 1.f, ni = ai;
        const float cr = (nr * lr + ni * li) / den, ci = (ni * lr - nr * li) / den;
        ((float*)(ws + SSM_AR))[gtid] = ar; ((float*)(ws + SSM_AI))[gtid] = ai;
        const float mag64 = expf(64.f * (lr * dt)); float sn64, cs64; sincosf(64.f * (li * dt), &sn64, &cs64);
        ((float*)(ws + SSM_ALR))[gtid] = mag64 * cs64; ((float*)(ws + SSM_ALI))[gtid] = mag64 * sn64;
        f32x2* BB = (f32x2*)(ws + SSM_BB);
#pragma unroll
        for (int c = 0; c < 16; ++c) { const float br = A.in[18][gtid * 16 + c], bi = A.in[19][gtid * 16 + c]; BB[gtid * 16 + c] = (f32x2){cr * br - ci * bi, cr * bi + ci * br}; }
        unsigned* CB = (unsigned*)(ws + SSM_CB); const int p = gtid & 63;
#pragma unroll
        for (int c = 0; c < 16; ++c) { const float c_r = A.in[20][(g * 16 + c) * 64 + p], c_i = A.in[21][(g * 16 + c) * 64 + p]; CB[(g * 16 + c) * 64 + p] = pk(c_r, -c_i); }
    }
    { bf16_t* KSF = (bf16_t*)(ws + WS_KSF); const float* ck = A.in[4];
      for (int idx = gtid; idx < 16 * 512 * 64; idx += NT) {
          const int c8 = idx & 63, t = (idx >> 6) & 511, b = idx >> 15, h = c8 >> 3, d0 = (c8 & 7) * 8;
          const float* s = ck + ((size_t)(b * 512 + t) * 512 + c8 * 8);
          const f32x4 v0 = __builtin_nontemporal_load((const f32x4*)s), v1 = __builtin_nontemporal_load((const f32x4*)(s + 4));
          const int tile = t >> 6, k64 = t & 63, kk = d0 >> 4, hi = (d0 >> 3) & 1;
          *(u32x4*)(KSF + ((size_t)(b * 8 + h) * 9 + tile) * 4096 + (((k64 >> 5) * 4 + kk) * 64 + (k64 & 31) + 32 * hi) * 8) = pk8(v0, v1);
      } }
    { bf16_t* VSF = (bf16_t*)(ws + WS_VSF); const float* cv = A.in[5];
      for (int idx = gtid; idx < 16 * 8 * 8 * 8 * 64; idx += NT) {
          const int ln = idx & 63, frag = (idx >> 6) & 7, tile = (idx >> 9) & 7, h = (idx >> 12) & 7, b = idx >> 15;
          const int dh = frag & 1, half = (frag >> 1) & 1, kh = frag >> 2, d = 32 * dh + (ln & 31), hi = ln >> 5;
          float v[8];
#pragma unroll
          for (int j = 0; j < 8; ++j) { const int key = 64 * tile + 32 * kh + 16 * half + 4 * hi + (j & 3) + 8 * (j >> 2); v[j] = __builtin_nontemporal_load(cv + ((size_t)(b * 512 + key) * 8 + h) * 64 + d); }
          u32x4 w; w.x = pk(v[0], v[1]); w.y = pk(v[2], v[3]); w.z = pk(v[4], v[5]); w.w = pk(v[6], v[7]);
          *(u32x4*)(VSF + ((size_t)(b * 8 + h) * 9 + tile) * 4096 + (frag * 64 + ln) * 8) = w;
      } }
    for (int idx = gtid; idx < 128 * 512; idx += NT) { const int bh = idx >> 9, w = idx & 511; const u32x4 z = {0u, 0u, 0u, 0u};
        *(u32x4*)(ws + WS_KSF + ((size_t)bh * 9 + 8) * 8192 + w * 16) = z; *(u32x4*)(ws + WS_VSF + ((size_t)bh * 9 + 8) * 8192 + w * 16) = z; }
}

DI float wave_sum(float v) {
#pragma unroll
    for (int o = 1; o < 64; o <<= 1) v += __shfl_xor(v, o);
    return v;
}
DI void p1_hnorm(const Args& A, int tid, int wave, int lane) {
    unsigned char* ws = A.ws; const float* MOD = (const float*)(ws + WS_MOD); const float* bada = A.in[10];
    if (tid < 64) { unsigned sp = 0;
        while ((unsigned)__builtin_amdgcn_readfirstlane(__hip_atomic_load((const unsigned*)MOD + MODCNT_WORD, __ATOMIC_RELAXED, __HIP_MEMORY_SCOPE_AGENT)) < 768u && ++sp < (1u << 20)) __builtin_amdgcn_s_sleep(4);
        __builtin_amdgcn_fence(__ATOMIC_ACQUIRE, "agent");
        asm volatile("s_waitcnt vmcnt(0)" ::: "memory"); }
    __syncthreads();
    const int gw = blockIdx.x * 8 + wave, NGW = gridDim.x * 8, gtid = blockIdx.x * 512 + tid;
    if (gtid < 18 * 1024) ((float*)(ws + WS_GATE))[gtid] = MOD[(gtid >> 10) * 3072 + 2048 + (gtid & 1023)] + bada[2048 + (gtid & 1023)];
    bf16_t* H = (bf16_t*)(ws + WS_H); const float* ng = A.in[8];
    for (int blk = gw; blk < MP / 8 + (MT - MP); blk += NGW) {
        const bool samp = blk >= MP / 8; const int m0 = samp ? MP + (blk - MP / 8) : 8 * blk, nr = samp ? 1 : 8;
        const float* xr = samp ? A.in[1] + (size_t)(m0 - MP) * 1024 : A.in[0] + (size_t)m0 * 1024;
        const int bi = samp ? 2 + ((m0 - MP) >> 4) : (m0 >> 13);
        f32x4 a1[4], b1[4];
#pragma unroll
        for (int j = 0; j < 4; ++j) { const int k = 4 * lane + 256 * j;
            b1[j] = *(const f32x4*)(MOD + bi * 3072 + k) + *(const f32x4*)(bada + k);
            a1[j] = *(const f32x4*)(ng + k) * (*(const f32x4*)(MOD + bi * 3072 + 1024 + k) + *(const f32x4*)(bada + 1024 + k) + 1.f); }
        f32x4 v[4], vn[4];
#pragma unroll
        for (int j = 0; j < 4; ++j) v[j] = __builtin_nontemporal_load((const f32x4*)(xr + 4 * lane + 256 * j));
        for (int r = 0; r < nr; ++r) {
            const float* xn = xr + (size_t)(r < nr - 1 ? r + 1 : r) * 1024;
#pragma unroll
            for (int j = 0; j < 4; ++j) vn[j] = __builtin_nontemporal_load((const f32x4*)(xn + 4 * lane + 256 * j));
            float ssq = 0.f;
#pragma unroll
            for (int j = 0; j < 4; ++j) ssq += (v[j].x * v[j].x + v[j].y * v[j].y) + (v[j].z * v[j].z + v[j].w * v[j].w);
            const float rstd = 1.0f / sqrtf(wave_sum(ssq) * (1.f / 1024.f) + RMS_EPS);
#pragma unroll
            for (int j = 0; j < 4; ++j) { const f32x4 h = v[j] * rstd * a1[j] + b1[j];
                u32x2 w; w.x = pk(h.x, h.y); w.y = pk(h.z, h.w); *(u32x2*)(H + (size_t)(m0 + r) * 1024 + 4 * lane + 256 * j) = w; v[j] = vn[j]; }
        }
    }
}

DI bf16x8 ld16(const bf16_t* p) { return *(const bf16x8*)p; }
DI bf16x8 pack8(const f32x16& s, int o) { u32x4 w; w.x = pk(s[o], s[o + 1]); w.y = pk(s[o + 2], s[o + 3]); w.z = pk(s[o + 4], s[o + 5]); w.w = pk(s[o + 6], s[o + 7]); return __builtin_bit_cast(bf16x8, w); }
DI void attn_unit(const bf16_t* qfp, const bf16_t* kfp, const bf16_t* vfp, int ntiles, int nkeys, int dq0, const LAS float* bt,
                  bf16_t* Op, const bf16_t* GAp, int qlo, int qhi, int lane) {
    const int q = lane & 31, hi = lane >> 5;
    bf16x8 qf[4];
#pragma unroll
    for (int kk = 0; kk < 4; ++kk) qf[kk] = ld16(qfp + (kk * 64 + lane) * 8);
    f32x16 o0, o1;
#pragma unroll
    for (int i = 0; i < 16; ++i) { o0[i] = 0.f; o1[i] = 0.f; }
    float mrun = -1e30f, lrun = 0.f;
    bf16x8 kc[8], vf[8];
#pragma unroll
    for (int f = 0; f < 8; ++f) kc[f] = ld16(kfp + (f * 64 + lane) * 8);
#pragma unroll
    for (int f = 0; f < 8; ++f) vf[f] = ld16(vfp + (f * 64 + lane) * 8);
    for (int t = 0; t < ntiles; ++t) {
        const int tn = (t + 1 < ntiles) ? t + 1 : t;
        bf16x8 vn[8];
        const bf16_t* vnp = vfp + (size_t)tn * 4096; const bf16_t* knp = kfp + (size_t)tn * 4096;
#pragma unroll
        for (int f = 0; f < 8; ++f) vn[f] = ld16(vnp + (f * 64 + lane) * 8);
        f32x16 s0, s1;
#pragma unroll
        for (int i = 0; i < 16; ++i) { s0[i] = 0.f; s1[i] = 0.f; }
#pragma unroll
        for (int kk = 0; kk < 4; ++kk) { s0 = MFMA32(kc[kk], qf[kk], s0); s1 = MFMA32(kc[4 + kk], qf[kk], s1); }
#pragma unroll
        for (int f = 0; f < 8; ++f) kc[f] = ld16(knp + (f * 64 + lane) * 8);
        float bc = 0.f;
        if (dq0 - 64 * t - 63 >= 128) { bc = bt[256]; } else {
            const LAS float* bp = bt + (dq0 + q - 64 * t - 4 * hi + 128);
#pragma unroll
            for (int i = 0; i < 16; ++i) { const int kidx = (i & 3) + 8 * (i >> 2); s0[i] += bp[-kidx]; s1[i] += bp[-kidx - 32]; }
        }
        if (64 * t + 64 > nkeys) {
#pragma unroll
            for (int i = 0; i < 16; ++i) { const int key = 64 * t + (i & 3) + 8 * (i >> 2) + 4 * hi;
                if (key >= nkeys) s0[i] = -1e30f;
                if (key + 32 >= nkeys) s1[i] = -1e30f; }
        }
        float tm = fmaxf(s0[0], s1[0]);
#pragma unroll
        for (int i = 1; i < 16; ++i) tm = fmaxf(tm, fmaxf(s0[i], s1[i]));
        tm = fmaxf(tm, __shfl_xor(tm, 32)) + bc;
        const float mnew = fmaxf(mrun, tm), alpha = ex2(mrun - mnew), moff = mnew - bc; mrun = mnew;
        float ls = 0.f;
#pragma unroll
        for (int i = 0; i < 16; ++i) { s0[i] = ex2(s0[i] - moff); s1[i] = ex2(s1[i] - moff); ls += s0[i] + s1[i]; }
        lrun = lrun * alpha + ls;
        if (__any(alpha != 1.0f)) {
#pragma unroll
            for (int i = 0; i < 16; ++i) { o0[i] *= alpha; o1[i] *= alpha; }
        }
        const bf16x8 p00 = pack8(s0, 0), p01 = pack8(s0, 8), p10 = pack8(s1, 0), p11 = pack8(s1, 8);
        o0 = MFMA32(vf[0], p00, o0); o1 = MFMA32(vf[1], p00, o1);
        o0 = MFMA32(vf[2], p01, o0); o1 = MFMA32(vf[3], p01, o1);
        o0 = MFMA32(vf[4], p10, o0); o1 = MFMA32(vf[5], p10, o1);
        o0 = MFMA32(vf[6], p11, o0); o1 = MFMA32(vf[7], p11, o1);
#pragma unroll
        for (int f = 0; f < 8; ++f) vf[f] = vn[f];
    }
    const float lt = lrun + __shfl_xor(lrun, 32), inv = 1.0f / lt;
    if (q >= qlo && q < qhi) {
#pragma unroll
        for (int g4 = 0; g4 < 4; ++g4) {
            const int d0 = 8 * g4 + 4 * hi;
            { const u32x2 ga = *(const u32x2*)(GAp + (size_t)q * 512 + d0); u32x2 w;
              w.x = pk(o0[4 * g4] * inv * bflo(ga.x), o0[4 * g4 + 1] * inv * bfhi(ga.x)); w.y = pk(o0[4 * g4 + 2] * inv * bflo(ga.y), o0[4 * g4 + 3] * inv * bfhi(ga.y));
              *(u32x2*)(Op + (size_t)q * 1024 + d0) = w; }
            { const u32x2 ga = *(const u32x2*)(GAp + (size_t)q * 512 + 32 + d0); u32x2 w;
              w.x = pk(o1[4 * g4] * inv * bflo(ga.x), o1[4 * g4 + 1] * inv * bfhi(ga.x)); w.y = pk(o1[4 * g4 + 2] * inv * bflo(ga.y), o1[4 * g4 + 3] * inv * bfhi(ga.y));
              *(u32x2*)(Op + (size_t)q * 1024 + 32 + d0) = w; }
        }
    }
}
DI void p3_bias(const Args& A, LAS unsigned char* lds, int tid) {
    LAS float* bt = (LAS float*)(lds + BIAS_OFF);
    for (int i = tid; i < 8 * 704; i += 512) { const int h = i / 704, r = i - h * 704; bt[i] = A.in[14][h * 257 + (r < 256 ? r : 256)] * LOG2E; }
    __syncthreads();
}
DI void p3_attn(const Args& A, LAS unsigned char* lds, int tid, int wave, int lane) {
    unsigned char* ws = A.ws;
    const LAS float* bt = (const LAS float*)(lds + BIAS_OFF);
    const int vb = (gridDim.x % 8 == 0) ? (int)(blockIdx.x % 8) * (int)(gridDim.x / 8) + (int)(blockIdx.x / 8) : (int)blockIdx.x;
    const int gw = vb * 8 + wave, NGW = gridDim.x * 8;
    const bf16_t* QF = (const bf16_t*)(ws + WS_QF); bf16_t* OA = (bf16_t*)(ws + WS_XCAT); const bf16_t* GA = (const bf16_t*)(ws + WS_GA);
    const bool deal = (NGW == 2048);
    for (int it = 0, L = deal ? (gw < 1920 ? gw : 1920 + gw) : gw; L < 3840 + 128; ++it, L = deal ? ((gw < 1920 && it < 2) ? gw + 1920 : 3968) : L + NGW) {
        const int nsub = (L < 3840) ? 1 : 3;
        for (int sub = 0; sub < nsub; ++sub) {
            int b, c, h, qh; bool samp = false;
            if (L < 3840) { qh = L & 1; h = (L >> 1) & 7; const int cc = L >> 4; c = 8 + (cc % 120); b = cc / 120; }
            else { const int w = L - 3840; if (sub == 2) { samp = true; h = w & 7; b = w >> 3; c = 0; qh = 0; }
                   else { qh = w & 1; h = (w >> 1) & 7; b = (w >> 4) & 1; const int cp = w >> 5; c = sub ? 7 - cp : cp; } }
            if (!samp) {
                const int nt = (c < 8 ? c : 8) + 1, c0 = c - nt + 1, row0 = b * 8192 + 64 * c + 32 * qh;
                attn_unit(QF + ((size_t)(row0 >> 5) * 8 + h) * 2048, (const bf16_t*)(ws + WS_KF) + ((size_t)(b * 8 + h) * 128 + c0) * 4096,
                          (const bf16_t*)(ws + WS_VF) + ((size_t)(b * 8 + h) * 128 + c0) * 4096, nt, nt * 64, 64 * (c - c0) + 32 * qh, bt + h * 704,
                          OA + (size_t)row0 * 1024 + h * 64, GA + (size_t)row0 * 512 + h * 64, 0, 32, lane);
            } else {
                const int row0 = MP + 32 * (b >> 1), qo = 16 * (b & 1);
                attn_unit(QF + ((size_t)(row0 >> 5) * 8 + h) * 2048, (const bf16_t*)(ws + WS_KSF) + ((size_t)(b * 8 + h) * 9) * 4096,
                          (const bf16_t*)(ws + WS_VSF) + ((size_t)(b * 8 + h) * 9) * 4096, 9, 528, 512 - qo, bt + h * 704,
                          OA + (size_t)row0 * 1024 + h * 64, GA + (size_t)row0 * 512 + h * 64, qo, qo + 16, lane);
            }
        }
    }
}

constexpr int BPITCH = 528;
DI void ssm_load_bb(const unsigned char* ws, int g, int lane, bf16x8 (&bbf)[4]) {
    const f32x2* BB = (const f32x2*)(ws + SSM_BB);
#pragma unroll
    for (int rt = 0; rt < 4; ++rt) { const int r = 32 * rt + (lane & 31), p = r >> 1, ri = r & 1, hi = lane >> 5; float v[8];
#pragma unroll
        for (int j = 0; j < 8; ++j) { const f32x2 e = BB[(size_t)(g * 64 + p) * 16 + 8 * hi + j]; v[j] = ri ? e.y : e.x; }
        u32x4 w; w.x = pk(v[0], v[1]); w.y = pk(v[2], v[3]); w.z = pk(v[4], v[5]); w.w = pk(v[6], v[7]); bbf[rt] = __builtin_bit_cast(bf16x8, w); }
}
typedef bf16x8 UReg;
DI UReg ssm_ld(const bf16_t* U, int row0, int g, int lane) { return ld16(U + (size_t)(row0 + (lane & 31)) * 512 + g * 16 + 8 * (lane >> 5)); }
template <bool FULL> DI void ssm_block32(f32x2& x, const bf16x8 (&bbf)[4], float ar, float ai, const UReg& ur, int ntok, LAS unsigned char* Bw, int lane) {
    const int tok = lane & 31, hi = lane >> 5;
    const bf16x8 ub = ur;
#pragma unroll
    for (int rt = 0; rt < 4; ++rt) {
        f32x16 d;
#pragma unroll
        for (int i = 0; i < 16; ++i) d[i] = 0.f;
        d = MFMA32(bbf[rt], ub, d);
#pragma unroll
        for (int a4 = 0; a4 < 4; ++a4) *(LAS f32x4*)(Bw + tok * BPITCH + (32 * rt + 8 * a4 + 4 * hi) * 4) = (f32x4){d[4 * a4], d[4 * a4 + 1], d[4 * a4 + 2], d[4 * a4 + 3]};
    }
    asm volatile("" ::: "memory");
#pragma unroll 8
    for (int t = 0; t < ntok; ++t) {
        const f32x2 bu = *(const LAS f32x2*)(Bw + t * BPITCH + 8 * lane);
        const float xr = ar * x.x - ai * x.y + bu.x, xi = ar * x.y + ai * x.x + bu.y;
        x.x = xr; x.y = xi;
        if (FULL) *(LAS unsigned*)(Bw + t * BPITCH + 4 * lane) = pk(xr, xi);
    }
    asm volatile("" ::: "memory");
}
constexpr size_t WS_SCNT = 254 * 1024;
DI void p3_ssmA(const Args& A, LAS unsigned char* lds, int wave, int lane) {
    unsigned char* ws = A.ws;
    const int gw = blockIdx.x * 8 + wave, NGW = gridDim.x * 8, g = gw & 31, gp = g * 64 + lane;
    const float ar = ((const float*)(ws + SSM_AR))[gp], ai = ((const float*)(ws + SSM_AI))[gp];
    bf16x8 bbf[4]; ssm_load_bb(ws, g, lane, bbf);
    const bf16_t* U = (const bf16_t*)(ws + WS_U); unsigned long long* E = (unsigned long long*)(ws + WS_E);
    LAS unsigned char* Bw = lds + wave * (32 * BPITCH);
    const float alr = ((const float*)(ws + SSM_ALR))[gp], ali = ((const float*)(ws + SSM_ALI))[gp];
    for (int qq = gw >> 5; qq < 64; qq += NGW >> 5) {
        const int b = qq >> 5, j0 = (qq & 31) * 4, row0 = b * 8192 + j0 * 64;
        f32x2 x, agg = {0.f, 0.f};
        for (int jj = 0; jj < 4; ++jj) {
            x = (f32x2){0.f, 0.f};
            const UReg u0 = ssm_ld(U, row0 + 64 * jj, g, lane), u1 = ssm_ld(U, row0 + 64 * jj + 32, g, lane);
            ssm_block32<false>(x, bbf, ar, ai, u0, 32, Bw, lane);
            ssm_block32<false>(x, bbf, ar, ai, u1, 32, Bw, lane);
            const float gr = alr * agg.x - ali * agg.y + x.x, gi = alr * agg.y + ali * agg.x + x.y; agg.x = gr; agg.y = gi;
        }
        __hip_atomic_store(E + ((size_t)(qq * 32 + g)) * 64 + lane, ((unsigned long long)__float_as_uint(agg.y) << 32) | __float_as_uint(agg.x), __ATOMIC_RELAXED, __HIP_MEMORY_SCOPE_AGENT);
        asm volatile("s_waitcnt vmcnt(0)" ::: "memory");
        if (lane == 0) __hip_atomic_fetch_add((unsigned*)(ws + WS_SCNT) + (b * 32 + g) * 4, 1u, __ATOMIC_RELAXED, __HIP_MEMORY_SCOPE_AGENT);
    }
}
DI void p4_ssmC(const Args& A, LAS unsigned char* lds, int wave, int lane) {
    unsigned char* ws = A.ws;
    const int gw = blockIdx.x * 8 + wave, NGW = gridDim.x * 8, g = gw & 31, gp = g * 64 + lane;
    const float ar = ((const float*)(ws + SSM_AR))[gp], ai = ((const float*)(ws + SSM_AI))[gp];
    const float alr = ((const float*)(ws + SSM_ALR))[gp], ali = ((const float*)(ws + SSM_ALI))[gp];
    bf16x8 bbf[4]; ssm_load_bb(ws, g, lane, bbf);
    bf16x8 cbf[4];
#pragma unroll
    for (int kk = 0; kk < 4; ++kk) cbf[kk] = ld16((const bf16_t*)(ws + SSM_CB) + (size_t)(g * 16 + (lane & 15)) * 128 + 32 * kk + 8 * (lane >> 4));
    const f32x4 dsk = *(const f32x4*)(A.in[22] + g * 16 + 4 * (lane >> 4));
    const bf16_t* U = (const bf16_t*)(ws + WS_U); bf16_t* Y = (bf16_t*)(ws + WS_Y);
    LAS unsigned char* Bw = lds + wave * (32 * BPITCH);
#define SSM_CPROJ(r0_, nt_) do { for (int tt = 0; tt < (nt_) / 16; ++tt) { f32x4 acc = {0.f, 0.f, 0.f, 0.f}; \
        _Pragma("unroll") for (int kk = 0; kk < 4; ++kk) { const bf16x8 xb = *(const LAS bf16x8*)(Bw + (16 * tt + (lane & 15)) * BPITCH + 64 * kk + 16 * (lane >> 4)); acc = MFMA16(cbf[kk], xb, acc); } \
        const int row = (r0_) + 16 * tt + (lane & 15); const u32x2 ub_ = *(const u32x2*)(U + (size_t)row * 512 + g * 16 + 4 * (lane >> 4)); const f32x4 uu = {bflo(ub_.x), bfhi(ub_.x), bflo(ub_.y), bfhi(ub_.y)}; const f32x4 y = acc + dsk * uu; \
        u32x2 w; w.x = pk(y.x, y.y); w.y = pk(y.z, y.w); *(u32x2*)(Y + (size_t)row * 512 + g * 16 + 4 * (lane >> 4)) = w; } asm volatile("" ::: "memory"); } while (0)
    for (int qq = gw >> 5; qq < 64; qq += NGW >> 5) {
        const int b = qq >> 5, j0 = (qq & 31) * 4, row0 = b * 8192 + j0 * 64;
        UReg u = ssm_ld(U, row0, g, lane);
        f32x2 x = {0.f, 0.f};
        if (j0 > 0) {
            unsigned* cnt = (unsigned*)(ws + WS_SCNT) + (b * 32 + g) * 4; unsigned sp = 0;
            while ((unsigned)__builtin_amdgcn_readfirstlane(__hip_atomic_load(cnt, __ATOMIC_RELAXED, __HIP_MEMORY_SCOPE_AGENT)) < 32u && ++sp < (1u << 22)) __builtin_amdgcn_s_sleep(2);
            const unsigned long long* ep = (const unsigned long long*)(ws + WS_E) + ((size_t)(b * 32) * 32 + g) * 64 + lane;
            const float a2r = alr * alr - ali * ali, a2i = 2.f * alr * ali, a4r = a2r * a2r - a2i * a2i, a4i = 2.f * a2r * a2i;
#pragma unroll 16
            for (int i = 0; i < (qq & 31); ++i) { const unsigned long long eb = __hip_atomic_load(ep + (size_t)i * 2048, __ATOMIC_RELAXED, __HIP_MEMORY_SCOPE_AGENT);
                const float ex = __uint_as_float((unsigned)eb), ey = __uint_as_float((unsigned)(eb >> 32));
                const float xr = a4r * x.x - a4i * x.y + ex, xi = a4r * x.y + a4i * x.x + ey; x.x = xr; x.y = xi; }
        }
        for (int blk = 0; blk < 8; ++blk) {
            const int r0 = row0 + 32 * blk;
            const UReg un = ssm_ld(U, row0 + 32 * (blk < 7 ? blk + 1 : blk), g, lane);
            ssm_block32<true>(x, bbf, ar, ai, u, 32, Bw, lane);
            SSM_CPROJ(r0, 32);
            u = un;
        }
        if (j0 == 124) { A.out[O4 + (b * 32 + g) * 64 + lane] = x.x; A.out[O5 + (b * 32 + g) * 64 + lane] = x.y; }
    }
    for (int su = gw; su < 512; su += NGW) {
        const int b = su >> 5, row0 = MP + b * 16;
        f32x2 x; x.x = A.in[6][(b * 32 + g) * 64 + lane]; x.y = A.in[7][(b * 32 + g) * 64 + lane];
        const UReg u = ssm_ld(U, row0, g, lane);
        ssm_block32<true>(x, bbf, ar, ai, u, 16, Bw, lane);
        SSM_CPROJ(row0, 16);
        A.out[O8 + (b * 32 + g) * 64 + lane] = x.x; A.out[O9 + (b * 32 + g) * 64 + lane] = x.y;
    }
#undef SSM_CPROJ
}

template <int K, int LDA, int LDB> DI void mini_part(const bf16_t* A, int row0, const bf16_t* Bt, int pr0, int pr1, LAS f32x4* red, int wave, int lane) {
    const int m = lane & 31, hi = lane >> 5, k0 = wave * (K / 8);
    const bf16_t* ap = A + (size_t)(row0 + m) * LDA + k0 + 8 * hi; const bf16_t* w0 = Bt + (size_t)(pr0 + m) * LDB + k0 + 8 * hi; const bf16_t* w1 = Bt + (size_t)(pr1 + m) * LDB + k0 + 8 * hi;
    f32x16 d0, d1;
#pragma unroll
    for (int i = 0; i < 16; ++i) { d0[i] = 0.f; d1[i] = 0.f; }
#pragma unroll
    for (int kk = 0; kk < K / 128; ++kk) { const bf16x8 x = ld16(ap + 16 * kk), wa = ld16(w0 + 16 * kk), wb = ld16(w1 + 16 * kk); d0 = MFMA32(wa, x, d0); d1 = MFMA32(wb, x, d1); }
#pragma unroll
    for (int a4 = 0; a4 < 4; ++a4) { red[(wave * 8 + a4) * 64 + lane] = (f32x4){d0[4 * a4], d0[4 * a4 + 1], d0[4 * a4 + 2], d0[4 * a4 + 3]};
                                     red[(wave * 8 + 4 + a4) * 64 + lane] = (f32x4){d1[4 * a4], d1[4 * a4 + 1], d1[4 * a4 + 2], d1[4 * a4 + 3]}; }
}
DI f32x4 mini_sum(const LAS f32x4* red, int ig, int lane) {
    f32x4 sacc = red[ig * 64 + lane];
#pragma unroll
    for (int w = 1; w < 8; ++w) sacc += red[(w * 8 + ig) * 64 + lane];
    return sacc;
}
#define MINI_TASKS(ntask_) for (int task = (int)blockIdx.x; task < (ntask_); task += (int)gridDim.x)
DI void mini_gemm1(const Args& A, LAS unsigned char* lds, int wave, int lane) {
    unsigned char* ws = A.ws; const int m = lane & 31, hi = lane >> 5, tl = wave >> 2, a = wave & 3, dc = 32 * tl + 8 * a + 4 * hi;
    LAS f32x4* red = (LAS f32x4*)lds; LAS float* sq = (LAS float*)(lds + 65536);
    MINI_TASKS(8 * 80) {
        const int rb = task & 7, cb = task >> 3, row0 = MP + 32 * rb, row = row0 + m, b = (row - MP) >> 4, t = row & 15;
        __syncthreads();
        mini_part<1024, 1024, 1024>((const bf16_t*)(ws + WS_H), row0, (const bf16_t*)(ws + WS_WIN), phys_std(64 * cb), phys_std(64 * cb + 32), red, wave, lane);
        __syncthreads();
        f32x4 v = mini_sum(red, wave, lane);
        if (cb < 16) {
            const bool isk = cb >= 8; const int head = cb & 7; const float* gp = isk ? A.in[13] : A.in[12];
            sq[m * 16 + wave * 2 + hi] = (v.x * v.x + v.y * v.y) + (v.z * v.z + v.w * v.w);
            __syncthreads();
            const LAS f32x4* sp = (const LAS f32x4*)(sq + m * 16); const f32x4 s0 = sp[0], s1 = sp[1], s2 = sp[2], s3 = sp[3];
            const float ss = ((s0.x + s0.y) + (s0.z + s0.w)) + ((s1.x + s1.y) + (s1.z + s1.w)) + ((s2.x + s2.y) + (s2.z + s2.w)) + ((s3.x + s3.y) + (s3.z + s3.w));
            const float rs = (1.0f / sqrtf(ss * (1.f / 64.f) + RMS_EPS)) * (isk ? 1.f : 0.125f * LOG2E);
            const int kk = dc >> 4, hq = (dc >> 3) & 1, j0 = dc & 7;
            v = v * *(const f32x4*)(gp + dc) * rs;
            u32x2 w; w.x = pk(v.x, v.y); w.y = pk(v.z, v.w);
            if (!isk) *(u32x2*)((bf16_t*)(ws + WS_QF) + ((size_t)(row >> 5) * 8 + head) * 2048 + (kk * 64 + (row & 31) + 32 * hq) * 8 + j0) = w;
            else { *(u32x2*)((bf16_t*)(ws + WS_KSF) + ((size_t)(b * 8 + head) * 9 + 8) * 4096 + (kk * 64 + t + 32 * hq) * 8 + j0) = w;
                   *(f32x4*)(A.out + O6 + ((size_t)(b * 16 + t) * 8 + head) * 64 + dc) = v; }
        } else if (cb < 24) {
            const int head = cb - 16, hik = (t >> 2) & 1, jk = (t & 3) + 4 * (t >> 3), dr = 8 * a + 4 * hi;
            bf16_t* dst = (bf16_t*)(ws + WS_VSF) + ((size_t)(b * 8 + head) * 9 + 8) * 4096 + ((tl * 64) + dr + 32 * hik) * 8 + jk;
            const unsigned w0 = pk(v.x, v.y), w1 = pk(v.z, v.w);
            dst[0] = (bf16_t)w0; dst[8] = (bf16_t)(w0 >> 16); dst[16] = (bf16_t)w1; dst[24] = (bf16_t)(w1 >> 16);
            *(f32x4*)(A.out + O7 + ((size_t)(b * 16 + t) * 8 + head) * 64 + dc) = v;
        } else if (cb >= 32 && cb < 40) {
            { u32x2 w; w.x = pk(v.x, v.y); w.y = pk(v.z, v.w); *(u32x2*)((bf16_t*)(ws + WS_U) + (size_t)row * 512 + (cb - 32) * 64 + dc) = w; }
        } else {
            bf16_t* base; int ld, c0; bool sil;
            if (cb < 32) { base = (bf16_t*)(ws + WS_GA); ld = 512; c0 = (cb - 24) * 64; sil = true; }
            else if (cb < 48) { base = (bf16_t*)(ws + WS_GS); ld = 512; c0 = (cb - 40) * 64; sil = true; }
            else if (cb < 64) { base = (bf16_t*)(ws + WS_MA); ld = 1024; c0 = (cb - 48) * 64; sil = false; }
            else { base = (bf16_t*)(ws + WS_MSG); ld = 1024; c0 = (cb - 64) * 64; sil = false; }
#pragma unroll
            for (int j = 0; j < 4; ++j) { const float sg = sigm(v[j]); v[j] = sil ? v[j] * sg : sg; }
            u32x2 w; w.x = pk(v.x, v.y); w.y = pk(v.z, v.w);
            *(u32x2*)(base + (size_t)row * ld + c0 + dc) = w;
        }
    }
    __syncthreads();
}
DI void mini_glu(const Args& A, LAS unsigned char* lds, int wave, int lane) {
    unsigned char* ws = A.ws; const int m = lane & 31, hi = lane >> 5; const float* bglu = A.in[24];
    LAS f32x4* red = (LAS f32x4*)lds;
    MINI_TASKS(8 * 16) {
        const int rb = task & 7, jb = task >> 3, row0 = MP + 32 * rb, row = row0 + m;
        __syncthreads();
        mini_part<512, 512, 512>((const bf16_t*)(ws + WS_Y), row0, (const bf16_t*)(ws + WS_WGLU), phys_glu(32 * jb), phys_glu(512 + 32 * jb), red, wave, lane);
        __syncthreads();
        if (wave < 4) {
            const int col = 32 * jb + 8 * wave + 4 * hi; const bf16_t* p = (const bf16_t*)(ws + WS_GS) + (size_t)row * 512 + col;
            f32x4 va = mini_sum(red, wave, lane) + *(const f32x4*)(bglu + col); const f32x4 vb = mini_sum(red, wave + 4, lane) + *(const f32x4*)(bglu + 512 + col);
            const u32x2 g = *(const u32x2*)p;
            va.x *= sigm(vb.x) * bflo(g.x); va.y *= sigm(vb.y) * bfhi(g.x); va.z *= sigm(vb.z) * bflo(g.y); va.w *= sigm(vb.w) * bfhi(g.y);
            u32x2 w; w.x = pk(va.x, va.y); w.y = pk(va.z, va.w); *(u32x2*)((bf16_t*)(ws + WS_XCAT) + (size_t)row * 1024 + 512 + col) = w;
        }
    }
    __syncthreads();
}
DI void mini_branch(const Args& A, LAS unsigned char* lds, int wave, int lane) {
    unsigned char* ws = A.ws; const int m = lane & 31, hi = lane >> 5, dc = 32 * (wave >> 2) + 8 * (wave & 3) + 4 * hi;
    LAS f32x4* red = (LAS f32x4*)lds;
    MINI_TASKS(8 * 16) {
        const int rb = task & 7, cb = task >> 3, row0 = MP + 32 * rb, row = row0 + m;
        __syncthreads();
        mini_part<512, 1024, 1024>((const bf16_t*)(ws + WS_XCAT), row0, (const bf16_t*)(ws + WS_WCAT), phys_std(64 * cb), phys_std(64 * cb + 32), red, wave, lane);
        __syncthreads();
        const f32x4 va = mini_sum(red, wave, lane);
        __syncthreads();
        mini_part<512, 1024, 1024>((const bf16_t*)(ws + WS_XCAT) + 512, row0, (const bf16_t*)(ws + WS_WCAT) + 512, phys_std(64 * cb), phys_std(64 * cb + 32), red, wave, lane);
        __syncthreads();
        const f32x4 vs = mini_sum(red, wave, lane);
        const size_t off = (size_t)row * 1024 + 64 * cb + dc;
        const u32x2 ga = *(const u32x2*)((const bf16_t*)(ws + WS_MA) + off), gs = *(const u32x2*)((const bf16_t*)(ws + WS_MSG) + off);
        u32x2 w; w.x = pk(va.x * bflo(ga.x) + vs.x * bflo(gs.x), va.y * bfhi(ga.x) + vs.y * bfhi(gs.x)); w.y = pk(va.z * bflo(ga.y) + vs.z * bflo(gs.y), va.w * bfhi(ga.y) + vs.w * bfhi(gs.y));
        *(u32x2*)((bf16_t*)(ws + WS_MERGED) + off) = w;
    }
    __syncthreads();
}
DI void mini_out(const Args& A, LAS unsigned char* lds, int wave, int lane) {
    unsigned char* ws = A.ws; const int m = lane & 31, hi = lane >> 5, dc = 32 * (wave >> 2) + 8 * (wave & 3) + 4 * hi; const float* gate = (const float*)(ws + WS_GATE);
    LAS f32x4* red = (LAS f32x4*)lds;
    MINI_TASKS(8 * 16) {
        const int rb = task & 7, cb = task >> 3, row0 = MP + 32 * rb, row = row0 + m, bi = 2 + ((row - MP) >> 4), col = 64 * cb + dc;
        __syncthreads();
        mini_part<1024, 1024, 1024>((const bf16_t*)(ws + WS_MERGED), row0, (const bf16_t*)(ws + WS_WOUT), phys_std(64 * cb), phys_std(64 * cb + 32), red, wave, lane);
        __syncthreads();
        const f32x4 v = mini_sum(red, wave, lane);
        *(f32x4*)(A.out + (size_t)row * 1024 + col) = *(const f32x4*)(A.in[1] + (size_t)(row - MP) * 1024 + col) + *(const f32x4*)(gate + bi * 1024 + col) * v;
    }
    __syncthreads();
}
#undef MINI_TASKS

#define XB_TMO      128
#define XB_XCNT(j)  (256  + 64 * (j))
#define XB_XSUB(j)  (1280 + 64 * (j))
#define XB_XGEN(j)  (2304 + 64 * (j))
#define XB_TOP      3328
#define XB_TOPGEN   3392
#define XCD_BAR_WORDS 3456
#define XB_SPIN_CAP (1u << 18)

__device__ __forceinline__ unsigned xb_ld(unsigned* p)              { return __hip_atomic_load(p, __ATOMIC_RELAXED, __HIP_MEMORY_SCOPE_AGENT); }
__device__ __forceinline__ unsigned xb_add(unsigned* p, unsigned v) { return __hip_atomic_fetch_add(p, v, __ATOMIC_RELAXED, __HIP_MEMORY_SCOPE_AGENT); }
__device__ __forceinline__ unsigned xb_xcc_id() { return (unsigned)__builtin_amdgcn_s_getreg((3 << 11) | 20) & 0xFu; }
#define XB_SPIN(cond, bar) do { unsigned _sp = 0; while (cond) { __builtin_amdgcn_s_sleep(1); \
    if ((++_sp & 255u) == 0u) { if (xb_ld(&(bar)[XB_TMO])) break; if (_sp > XB_SPIN_CAP) { atomicAdd(&(bar)[XB_TMO], 1u); break; } } } } while (0)

struct XcdBarrier {
    unsigned* bar; unsigned x;
    volatile LAS unsigned* st;
};

__device__ __forceinline__ XcdBarrier xcd_barrier_post(unsigned* bar, volatile LAS unsigned* st) {
    XcdBarrier b; b.bar = bar; b.x = xb_xcc_id(); b.st = st;
    if (threadIdx.x == 0) (void)xb_add(&bar[XB_XCNT(b.x)], 1u);
    return b;
}
__device__ __forceinline__ void xcd_barrier_complete(unsigned* bar, unsigned x, unsigned& nloc, unsigned& nx) {
    const unsigned G = gridDim.x * gridDim.y * gridDim.z;
    unsigned sum, cnt, mine, sp = 0u;
    for (;;) {
        sum = 0u; cnt = 0u; mine = 0u;
#pragma unroll
        for (unsigned j = 0; j < 16; ++j) { const unsigned c = xb_ld(&bar[XB_XCNT(j)]); sum += c; cnt += (c > 0u) ? 1u : 0u; mine = (j == x) ? c : mine; }
        if (sum == G) break;
        __builtin_amdgcn_s_sleep(1);
        if ((++sp & 255u) == 0u) { if (xb_ld(&bar[XB_TMO])) break; if (sp > XB_SPIN_CAP) { atomicAdd(&bar[XB_TMO], 1u); break; } }
    }
    nloc = mine > 0u ? mine : 1u; nx = cnt > 0u ? cnt : 1u;
}

__device__ __forceinline__ void xcd_barrier(const XcdBarrier& b) {
    asm volatile("s_waitcnt vmcnt(0)" ::: "memory");
    __syncthreads();
    if (threadIdx.x == 0) {
        unsigned* bar = b.bar;
        __builtin_amdgcn_s_waitcnt(0);
        unsigned nloc = b.st[0], nx = b.st[1];
        if (nloc == 0u) { xcd_barrier_complete(bar, b.x, nloc, nx); b.st[0] = nloc; b.st[1] = nx; }
        const unsigned old = xb_add(&bar[XB_XSUB(b.x)], 1u);
        const unsigned gen = old / nloc;
        if (old + 1u == (gen + 1u) * nloc) {
            __builtin_amdgcn_fence(__ATOMIC_RELEASE, "agent");
            asm volatile("s_waitcnt vmcnt(0)" ::: "memory");
            const unsigned og = xb_add(&bar[XB_TOP], 1u);
            const unsigned tg = og / nx;
            if (og + 1u == (tg + 1u) * nx) xb_add(&bar[XB_TOPGEN], 1u);
            else XB_SPIN(xb_ld(&bar[XB_TOPGEN]) == tg, bar);
            __builtin_amdgcn_fence(__ATOMIC_ACQUIRE, "agent");
            xb_add(&bar[XB_XGEN(b.x)], 1u);
            asm volatile("s_waitcnt vmcnt(0)" ::: "memory");
        } else {
            XB_SPIN(xb_ld(&bar[XB_XGEN(b.x)]) == gen, bar);
            __builtin_amdgcn_fence(__ATOMIC_ACQUIRE, "agent");
            asm volatile("s_waitcnt vmcnt(0)" ::: "memory");
        }
    }
    __syncthreads();
}

__global__ void __launch_bounds__(512, 2) mk_fwd(Args A) {
    extern __shared__ __attribute__((aligned(16))) unsigned char lds_raw[];
    LAS unsigned char* lds = (LAS unsigned char*)lds_raw;
    cg::grid_group grid = cg::this_grid();
    const int tid = threadIdx.x, lane = tid & 63, wave = __builtin_amdgcn_readfirstlane(tid >> 6);
    const int lo = A.ph_lo, hi = A.ph_hi, G = gridDim.x;
    unsigned char* ws = A.ws;
    if (hi > 1000) grid.sync();
    volatile LAS unsigned* xst = (volatile LAS unsigned*)(lds + LDS_BYTES - 64);
    if (tid < 16) xst[tid] = 0u;
    __syncthreads();
    XcdBarrier xbar; xbar.bar = (unsigned*)(ws + WS_BAR); xbar.x = 0; xbar.st = nullptr;
    if (hi - lo > 1) xbar = xcd_barrier_post((unsigned*)(ws + WS_BAR), xst);
#define IN(k) (lo <= (k) && (k) < hi)
#ifndef REP_SYNC
#define REP_SYNC 1
#endif
#ifndef REP_G1
#define REP_G1 1
#endif
#ifndef REP_AT
#define REP_AT 1
#endif
#ifndef REP_SS
#define REP_SS 1
#endif
#ifndef REP_TAIL
#define REP_TAIL 1
#endif
#define SEAM(k) do { if (IN(k) && (IN((k) + 1) || ((k) == 3 && IN(5)))) { for (int r_ = 0; r_ < REP_SYNC; ++r_) xcd_barrier(xbar); } } while (0)
    #ifndef REP_P0
#define REP_P0 1
#endif
    if (IN(0)) { p0_prep(A, lds, tid, wave, lane); for (int r_ = 1; r_ < REP_P0; ++r_) { __syncthreads(); p0_prep(A, lds, tid, wave, lane, false); } }
    #ifndef REP_P1
#define REP_P1 1
#endif
#ifndef REP_P6
#define REP_P6 1
#endif
#ifndef REP_P7
#define REP_P7 1
#endif
    if (IN(1)) { for (int r_ = 0; r_ < REP_P1; ++r_) p1_hnorm(A, tid, wave, lane); } SEAM(1);
    if (IN(2)) {
        pg8::Gemm g{(const bf16_t*)(ws + WS_H), (const bf16_t*)(ws + WS_WIN), MP, 5120, 1024}; pg8::StaticOrder S; S.init(MP, 5120, G, (int)blockIdx.x);
        Epi1 E{ws, A.out, A.in[12], A.in[13]};
        pg8::gemm_phase<Epi1, pg8::StaticOrder, true, true>(lds, g, S, E);
#if REP_G1 == 2
        pg8::gemm_phase<Epi1, pg8::StaticOrder, true, true>(lds, g, S, E);
#endif
        mini_gemm1(A, lds, wave, lane);
    } SEAM(2);
    if (IN(3)) {
        p3_bias(A, lds, tid);
        if (wave < 4) { p3_attn(A, lds, tid, wave, lane); p3_ssmA(A, lds, wave, lane); }
        else          { p3_ssmA(A, lds, wave, lane); p3_attn(A, lds, tid, wave, lane); }
        p4_ssmC(A, lds, wave, lane);
    } SEAM(3);
    if (IN(5)) {
        pg8::Gemm g{(const bf16_t*)(ws + WS_Y), (const bf16_t*)(ws + WS_WGLU), MP, 1024, 512}; pg8::StaticOrder S; S.init(MP, 1024, G, (int)blockIdx.x);
        EpiGLU E{(const bf16_t*)(ws + WS_GS), (bf16_t*)(ws + WS_XCAT), A.in[24]};
        pg8::gemm_phase<EpiGLU, pg8::StaticOrder, true, true>(lds, g, S, E);
        mini_glu(A, lds, wave, lane);
    } SEAM(5);
    if (IN(6)) {
        mini_branch(A, lds, wave, lane);
        pg8::StaticOrder S; S.init(MP, 1024, G, (int)blockIdx.x);
        pg8::Gemm g{(const bf16_t*)(ws + WS_XCAT), (const bf16_t*)(ws + WS_WCAT), MP, 1024, 1024}; EpiCat E{(bf16_t*)(ws + WS_MERGED), (const bf16_t*)(ws + WS_MA), (const bf16_t*)(ws + WS_MSG)};
        pg8::gemm_phase<EpiCat, pg8::StaticOrder, true, true>(lds, g, S, E);
    } SEAM(6);
    if (IN(7)) {
        pg8::Gemm g{(const bf16_t*)(ws + WS_MERGED), (const bf16_t*)(ws + WS_WOUT), MP, 1024, 1024}; pg8::StaticOrder S; S.init(MP, 1024, G, (int)blockIdx.x);
        EpiOut E{A.in[0], A.in[1], (const float*)(ws + WS_GATE), A.out};
        pg8::gemm_phase<EpiOut, pg8::StaticOrder, true, true>(lds, g, S, E);
        mini_out(A, lds, wave, lane);
#if REP_P7 == 2
        pg8::gemm_phase<EpiOut, pg8::StaticOrder, true, true>(lds, g, S, E);
#endif
    }
#undef IN
#undef SEAM
}

extern "C" void kernel_launch(void* const* d_in, const int* in_sizes, int n_in, void* d_out, int out_size, void* d_ws, size_t ws_size, hipStream_t stream) {
    static int grid = 0;
    if (grid == 0) {
        if (n_in != 28 || (size_t)out_size != OUT_TOTAL || ws_size < WS_END) { fprintf(stderr, "kernel_launch: unexpected shapes n_in %d out %d ws %zu\n", n_in, out_size, ws_size); grid = -1; return; }
        int dev = 0, cus = 0, per_cu = 0;
        hipGetDevice(&dev); hipDeviceGetAttribute(&cus, hipDeviceAttributeMultiprocessorCount, dev);
        if (hipFuncSetAttribute((const void*)mk_fwd, hipFuncAttributeMaxDynamicSharedMemorySize, LDS_BYTES) != hipSuccess) { fprintf(stderr, "kernel_launch: hipFuncSetAttribute failed\n"); grid = -1; return; }
        if (hipOccupancyMaxActiveBlocksPerMultiprocessor(&per_cu, (const void*)mk_fwd, 512, LDS_BYTES) != hipSuccess || per_cu < 1) { fprintf(stderr, "kernel_launch: occupancy query says %d\n", per_cu); (void)hipGetLastError(); per_cu = 1; }
        grid = cus * 1;
        if (grid % 4 != 0) grid -= grid % 4;
    }
    if (grid < 0) return;
    (void)hipMemsetAsync((char*)d_ws + WS_MOD, 0, CTL_ZERO_BYTES, stream);
    Args a{};
    for (int i = 0; i < 28; ++i) a.in[i] = (const float*)d_in[i];
    a.out = (float*)d_out; a.ws = (unsigned char*)d_ws;
#if MK_N_LAUNCHES == 1
    a.ph_lo = 0; a.ph_hi = NPH;
    void* args[] = {&a};
    hipError_t e = hipLaunchCooperativeKernel((const void*)mk_fwd, dim3(grid), dim3(512), args, LDS_BYTES, stream);
    if (e != hipSuccess) fprintf(stderr, "kernel_launch: cooperative launch failed: %s (grid %d)\n", hipGetErrorString(e), grid);
#else
    for (int p = 0; p < NPH; ++p) { a.ph_lo = p; a.ph_hi = p + 1; hipLaunchKernelGGL(mk_fwd, dim3(grid), dim3(512), LDS_BYTES, stream, a); }
#endif
}
```
